# Optimizing an MI355X kernel written in HIP

```python
import jax
import jax.numpy as jnp
from jax import lax
import numpy as np

D_MODEL = 2048
BATCH = 4
SEQ = 2048
DEPTH = 4
DEC_BATCH = 32
DEC_SEQ = 8
PAST_LEN = 16384
PAGE_SIZE = 128

D_FF = 5632
FFN_RES_WEIGHT = 0.5
POOL_WIDTH = D_MODEL // 2
POOL_WINDOWS = (2, 4, 8, 16)
POOL_GROUPS = len(POOL_WINDOWS)
POOL_GROUP_DIM = POOL_WIDTH // POOL_GROUPS
POOL_KEEP = max(POOL_WINDOWS) - 1
HEAD_DIM = 64
N_HEADS = D_MODEL // 128
N_KV_HEADS = 4
GQA_GROUP = N_HEADS // N_KV_HEADS
ATTN_WIDTH = N_HEADS * HEAD_DIM
KV_WIDTH = N_KV_HEADS * HEAD_DIM
WINDOW = 128
Q_BLOCK = 128
ROT_DIM = HEAD_DIM // 4
ROPE_THETA = 500000.0
LRU_WIDTH = D_MODEL // 2
LRU_BLOCKS = 16
LRU_BLOCK_DIM = LRU_WIDTH // LRU_BLOCKS
CONV_WIDTH = 4
LRU_C = 8.0
N_BRANCHES = 3
IN_WIDTHS = (POOL_WIDTH, ATTN_WIDTH, KV_WIDTH, KV_WIDTH, LRU_WIDTH, LRU_WIDTH, N_BRANCHES * D_MODEL)
IN_COLS = sum(IN_WIDTHS)
RMS_EPS = 1e-6
NEG_INF = -1e30

kernel_name = "hybrid_pool_swa_rglru_macaron_step"


def _split_points():
    pts, acc = [], 0
    for w in IN_WIDTHS[:-1]:
        acc += w
        pts.append(acc)
    return pts


def rms_norm(x, g):
    xf = x.astype(jnp.float32)
    y = xf * lax.rsqrt(jnp.mean(xf * xf, axis=-1, keepdims=True) + RMS_EPS)
    return (y * g.astype(jnp.float32)).astype(x.dtype)


def swiglu_ffn(x, w_gu, w_down):
    g, u = jnp.split(x @ w_gu, 2, axis=-1)
    return (jax.nn.silu(g) * u) @ w_down


def rotary(x, pos):
    half = ROT_DIM // 2
    inv = ROPE_THETA ** (-jnp.arange(half, dtype=jnp.float32) / half)
    ang = pos.astype(jnp.float32)[:, None] * inv[None, :]
    cos = jnp.cos(ang)[None, :, None, :]
    sin = jnp.sin(ang)[None, :, None, :]
    xr = x[..., :ROT_DIM].astype(jnp.float32)
    x1, x2 = xr[..., :half], xr[..., half:]
    rot = jnp.concatenate([x1 * cos - x2 * sin, x2 * cos + x1 * sin], axis=-1).astype(x.dtype)
    return jnp.concatenate([rot, x[..., ROT_DIM:]], axis=-1)


def pool_mixer(u, past, pos, w_grp, scale):
    B, T, _ = u.shape
    full = jnp.concatenate([past, u], axis=1)
    cs = jnp.cumsum(full.astype(jnp.float32), axis=1)
    cs = jnp.concatenate([jnp.zeros((B, 1, POOL_WIDTH), jnp.float32), cs], axis=1)
    means = []
    for g, w in enumerate(POOL_WINDOWS):
        lo_c, hi_c = g * POOL_GROUP_DIM, (g + 1) * POOL_GROUP_DIM
        hi = cs[:, POOL_KEEP + 1:POOL_KEEP + 1 + T, lo_c:hi_c]
        lo = cs[:, POOL_KEEP + 1 - w:POOL_KEEP + 1 - w + T, lo_c:hi_c]
        cnt = jnp.minimum(pos + 1, w).astype(jnp.float32)[None, :, None]
        means.append((hi - lo) / cnt)
    mean = jnp.concatenate(means, axis=-1).astype(u.dtype)
    d = (mean - u).reshape(B, T, POOL_GROUPS, POOL_GROUP_DIM)
    out = jnp.einsum('btgc,gcd->btgd', d, w_grp).reshape(B, T, POOL_WIDTH)
    return out * scale, full[:, -POOL_KEEP:]


def sliding_window_attention(q, k, v, k_past, v_past, pos0, sinks):
    B, T = q.shape[0], q.shape[1]
    qb = min(Q_BLOCK, T)
    nb = -(-T // qb)
    tp = nb * qb
    pad = ((0, 0), (0, tp - T), (0, 0), (0, 0))
    k_all = jnp.concatenate([k_past, jnp.pad(k, pad)], axis=1)
    v_all = jnp.concatenate([v_past, jnp.pad(v, pad)], axis=1)
    span = WINDOW + qb
    idx = jnp.arange(nb)[:, None] * qb + jnp.arange(span)[None, :]
    kb = jnp.take(k_all, idx, axis=1)
    vb = jnp.take(v_all, idx, axis=1)
    qblk = jnp.pad(q, pad).reshape(B, nb, qb, N_KV_HEADS, GQA_GROUP, HEAD_DIM)
    s = jnp.einsum('bnqkgd,bnskd->bnkgqs', qblk, kb).astype(jnp.float32) * (HEAD_DIM ** -0.5)
    q_pos = pos0 + jnp.arange(tp).reshape(nb, qb)
    k_pos = pos0 - WINDOW + idx
    rel = q_pos[:, :, None] - k_pos[:, None, :]
    valid = (k_pos[:, None, :] >= 0) & (rel >= 0) & (rel <= WINDOW)
    s = jnp.where(valid[None, :, None, None, :, :], s, NEG_INF)
    sink = sinks.astype(jnp.float32).reshape(N_KV_HEADS, GQA_GROUP)[None, None, :, :, None, None]
    m = jnp.maximum(jnp.max(s, axis=-1, keepdims=True), sink)
    p = jnp.exp(s - m)
    p = (p / (jnp.sum(p, axis=-1, keepdims=True) + jnp.exp(sink - m))).astype(v.dtype)
    o = jnp.einsum('bnkgqs,bnskd->bnqkgd', p, vb).reshape(B, tp, ATTN_WIDTH)[:, :T]
    return o, k_all[:, T:T + WINDOW], v_all[:, T:T + WINDOW]


def rglru_mixer(xb, g_in, conv_past, h0, conv_w, conv_b, wa, ba, wx, bx, lam):
    B, T, _ = xb.shape
    full = jnp.concatenate([conv_past, xb], axis=1)
    xc = conv_b + full[:, 0:T] * conv_w[0]
    for j in range(1, CONV_WIDTH):
        xc = xc + full[:, j:j + T] * conv_w[j]
    xr = xc.reshape(B, T, LRU_BLOCKS, LRU_BLOCK_DIM)
    r = jax.nn.sigmoid((jnp.einsum('bthc,hcd->bthd', xr, wa).reshape(B, T, LRU_WIDTH) + ba).astype(jnp.float32))
    i = jax.nn.sigmoid((jnp.einsum('bthc,hcd->bthd', xr, wx).reshape(B, T, LRU_WIDTH) + bx).astype(jnp.float32))
    log_a = -LRU_C * r * jax.nn.softplus(-lam.astype(jnp.float32))
    a = jnp.exp(log_a)
    b = jnp.sqrt(-jnp.expm1(2.0 * log_a)) * (i * xc.astype(jnp.float32))
    b = b.at[:, 0].add(a[:, 0] * h0.astype(jnp.float32))

    def combine(left, right):
        a1, b1 = left
        a2, b2 = right
        return a1 * a2, a2 * b1 + b2

    _, h = lax.associative_scan(combine, (a, b), axis=1)
    y = h.astype(xb.dtype) * jax.nn.gelu(g_in)
    return y, full[:, -(CONV_WIDTH - 1):], h[:, -1].astype(h0.dtype)


def trunk_layer(x, pos0, pool_past, k_past, v_past, conv_past, h0, lw):
    B, T, _ = x.shape
    x = x + FFN_RES_WEIGHT * swiglu_ffn(rms_norm(x, lw['norm_ffa']), lw['ffa_w_gu'], lw['ffa_w_down'])
    h = rms_norm(x, lw['norm_mix'])
    z = h @ lw['w_in']
    u_pool, q, k, v, x_lru, g_lru, gates = jnp.split(z, _split_points(), axis=-1)
    pos = pos0 + jnp.arange(T)
    pool_out, new_pool = pool_mixer(u_pool, pool_past, pos, lw['pool_w'], lw['pool_scale'])
    q = rotary(rms_norm(q.reshape(B, T, N_HEADS, HEAD_DIM), lw['q_norm']), pos)
    k = rotary(rms_norm(k.reshape(B, T, N_KV_HEADS, HEAD_DIM), lw['k_norm']), pos)
    v = v.reshape(B, T, N_KV_HEADS, HEAD_DIM)
    attn_out, new_k, new_v = sliding_window_attention(q, k, v, k_past, v_past, pos0, lw['attn_sinks'])
    lru_out, new_conv, new_h = rglru_mixer(x_lru, g_lru, conv_past, h0, lw['conv_w'], lw['conv_b'],
                                           lw['lru_gate_a_w'], lw['lru_gate_a_b'],
                                           lw['lru_gate_x_w'], lw['lru_gate_x_b'], lw['lru_lambda'])
    g = jax.nn.sigmoid(gates.reshape(B, T, N_BRANCHES, D_MODEL))
    merged = (g[:, :, 0] * (pool_out @ lw['w_branch_pool'])
              + g[:, :, 1] * (attn_out @ lw['w_branch_attn'])
              + g[:, :, 2] * (lru_out @ lw['w_branch_lru']))
    x = x + merged @ lw['w_out']
    x = x + FFN_RES_WEIGHT * swiglu_ffn(rms_norm(x, lw['norm_ffb']), lw['ffb_w_gu'], lw['ffb_w_down'])
    return x, (new_pool, new_k, new_v, new_conv, new_h)


def setup_inputs(seed: int = 0) -> dict:
    key = jax.random.key(seed)
    ks = iter(jax.random.split(key, 48))
    f32 = jnp.float32

    def nrm(shape, scale):
        return scale * jax.random.normal(next(ks), shape, f32)

    def gain(shape):
        return 1.0 + nrm(shape, 0.02)

    sw_keep = min(WINDOW, PAST_LEN)
    a8 = jax.random.uniform(next(ks), (DEPTH, LRU_WIDTH), f32, 0.9, 0.999)
    a_base = a8 ** (1.0 / LRU_C)
    return {
        'x_prompt': nrm((BATCH, SEQ, D_MODEL), 1.0),
        'x_sample': nrm((DEC_BATCH, DEC_SEQ, D_MODEL), 1.0),
        'state_pool': nrm((DEPTH, DEC_BATCH, POOL_KEEP, POOL_WIDTH), 1.0),
        'cache_k_win': nrm((DEPTH, DEC_BATCH, sw_keep, N_KV_HEADS, HEAD_DIM), 1.0),
        'cache_v_win': nrm((DEPTH, DEC_BATCH, sw_keep, N_KV_HEADS, HEAD_DIM), 1.0),
        'state_conv': nrm((DEPTH, DEC_BATCH, CONV_WIDTH - 1, LRU_WIDTH), 1.0),
        'state_rglru': nrm((DEPTH, DEC_BATCH, LRU_WIDTH), 0.5),
        'norm_ffa': gain((DEPTH, D_MODEL)),
        'ffa_w_gu': nrm((DEPTH, D_MODEL, 2 * D_FF), D_MODEL ** -0.5),
        'ffa_w_down': nrm((DEPTH, D_FF, D_MODEL), D_FF ** -0.5),
        'norm_mix': gain((DEPTH, D_MODEL)),
        'w_in': nrm((DEPTH, D_MODEL, IN_COLS), D_MODEL ** -0.5),
        'pool_w': nrm((DEPTH, POOL_GROUPS, POOL_GROUP_DIM, POOL_GROUP_DIM), POOL_GROUP_DIM ** -0.5),
        'pool_scale': gain((DEPTH, POOL_WIDTH)),
        'q_norm': gain((DEPTH, HEAD_DIM)),
        'k_norm': gain((DEPTH, HEAD_DIM)),
        'attn_sinks': nrm((DEPTH, N_HEADS), 0.5),
        'conv_w': nrm((DEPTH, CONV_WIDTH, LRU_WIDTH), CONV_WIDTH ** -0.5),
        'conv_b': nrm((DEPTH, LRU_WIDTH), 0.01),
        'lru_gate_a_w': nrm((DEPTH, LRU_BLOCKS, LRU_BLOCK_DIM, LRU_BLOCK_DIM), LRU_BLOCK_DIM ** -0.5),
        'lru_gate_a_b': nrm((DEPTH, LRU_WIDTH), 0.01),
        'lru_gate_x_w': nrm((DEPTH, LRU_BLOCKS, LRU_BLOCK_DIM, LRU_BLOCK_DIM), LRU_BLOCK_DIM ** -0.5),
        'lru_gate_x_b': nrm((DEPTH, LRU_WIDTH), 0.01),
        'lru_lambda': jnp.log(a_base) - jnp.log1p(-a_base),
        'w_branch_pool': nrm((DEPTH, POOL_WIDTH, D_MODEL), POOL_WIDTH ** -0.5),
        'w_branch_attn': nrm((DEPTH, ATTN_WIDTH, D_MODEL), ATTN_WIDTH ** -0.5),
        'w_branch_lru': nrm((DEPTH, LRU_WIDTH, D_MODEL), LRU_WIDTH ** -0.5),
        'w_out': nrm((DEPTH, D_MODEL, D_MODEL), D_MODEL ** -0.5),
        'norm_ffb': gain((DEPTH, D_MODEL)),
        'ffb_w_gu': nrm((DEPTH, D_MODEL, 2 * D_FF), D_MODEL ** -0.5),
        'ffb_w_down': nrm((DEPTH, D_FF, D_MODEL), D_FF ** -0.5),
    }


def reference(x_prompt, x_sample, state_pool, cache_k_win, cache_v_win, state_conv, state_rglru,
              norm_ffa, ffa_w_gu, ffa_w_down, norm_mix, w_in, pool_w, pool_scale, q_norm, k_norm,
              attn_sinks, conv_w, conv_b, lru_gate_a_w, lru_gate_a_b, lru_gate_x_w, lru_gate_x_b,
              lru_lambda, w_branch_pool, w_branch_attn, w_branch_lru, w_out, norm_ffb, ffb_w_gu,
              ffb_w_down):
    bp = x_prompt.shape[0]
    dt = x_prompt.dtype
    z_pool = jnp.zeros((bp, POOL_KEEP, POOL_WIDTH), dt)
    z_kv = jnp.zeros((bp, WINDOW, N_KV_HEADS, HEAD_DIM), dt)
    z_conv = jnp.zeros((bp, CONV_WIDTH - 1, LRU_WIDTH), dt)
    z_h = jnp.zeros((bp, LRU_WIDTH), state_rglru.dtype)

    yp, ys = x_prompt, x_sample
    st_p = ([], [], [], [], [])
    st_s = ([], [], [], [], [])
    for l in range(DEPTH):
        lw = {
            'norm_ffa': norm_ffa[l], 'ffa_w_gu': ffa_w_gu[l], 'ffa_w_down': ffa_w_down[l],
            'norm_mix': norm_mix[l], 'w_in': w_in[l], 'pool_w': pool_w[l], 'pool_scale': pool_scale[l],
            'q_norm': q_norm[l], 'k_norm': k_norm[l], 'attn_sinks': attn_sinks[l],
            'conv_w': conv_w[l], 'conv_b': conv_b[l],
            'lru_gate_a_w': lru_gate_a_w[l], 'lru_gate_a_b': lru_gate_a_b[l],
            'lru_gate_x_w': lru_gate_x_w[l], 'lru_gate_x_b': lru_gate_x_b[l],
            'lru_lambda': lru_lambda[l],
            'w_branch_pool': w_branch_pool[l], 'w_branch_attn': w_branch_attn[l],
            'w_branch_lru': w_branch_lru[l], 'w_out': w_out[l],
            'norm_ffb': norm_ffb[l], 'ffb_w_gu': ffb_w_gu[l], 'ffb_w_down': ffb_w_down[l],
        }
        yp, sp = trunk_layer(yp, 0, z_pool, z_kv, z_kv, z_conv, z_h, lw)
        ys, ss = trunk_layer(ys, PAST_LEN, state_pool[l], cache_k_win[l], cache_v_win[l],
                             state_conv[l], state_rglru[l], lw)
        for j in range(5):
            st_p[j].append(sp[j])
            st_s[j].append(ss[j])

    new_pool_p = jnp.stack(st_p[0])
    new_pool_s = jnp.stack(st_s[0])
    new_k_p = jnp.stack(st_p[1])
    new_k_s = jnp.stack(st_s[1])
    new_v_p = jnp.stack(st_p[2])
    new_v_s = jnp.stack(st_s[2])
    new_conv_p = jnp.stack(st_p[3])
    new_conv_s = jnp.stack(st_s[3])
    new_h_p = jnp.stack(st_p[4])
    new_h_s = jnp.stack(st_s[4])
    return (yp, ys, new_pool_p, new_pool_s, new_k_p, new_k_s, new_v_p, new_v_s,
            new_conv_p, new_conv_s, new_h_p, new_h_s)
```

```cpp
#include <hip/hip_runtime.h>
#include <cstdio>
#include <cstdint>

#ifndef MK_PER_PHASE
#define MK_PER_PHASE 0
#endif
#ifndef EN_MASK
#define EN_MASK 0xFFFF
#endif
#define EN(b) ((EN_MASK >> (b)) & 1)
#ifndef REP_MASK
#define REP_MASK 0
#endif
#define REPS(b) (1 + ((REP_MASK >> (b)) & 1))

#define LAS __attribute__((address_space(3)))
#define GAS __attribute__((address_space(1)))
typedef unsigned short bf16_t;
typedef short bf16x8 __attribute__((ext_vector_type(8)));
typedef float f32x4 __attribute__((ext_vector_type(4)));
typedef float f32x2 __attribute__((ext_vector_type(2)));
typedef unsigned u32x4 __attribute__((ext_vector_type(4)));
typedef unsigned u32x2 __attribute__((ext_vector_type(2)));

constexpr int D = 2048, MP = 8192, MS = 256, M = MP + MS, DEPTH = 4;
constexpr int FF = 5632, NGU = 2 * FF, NIN = 10752, NBR = 3072;
constexpr int ZC_Q = 1024, ZC_K = 2048, ZC_V = 2304, ZC_XL = 2560, ZC_GL = 3584, ZC_G = 4608;
constexpr int BRC_POOL = 0, BRC_ATT = 1024, BRC_LRU = 2048;
constexpr float RMS_EPS = 1e-6f;
constexpr int NSEQ = 36, NCHUNK = 32;
constexpr int N_ATT_UNITS = 256 + 128;
constexpr int N_LRU_ITEMS = 2048 + 512;

constexpr size_t O_Y = 0;
constexpr size_t O_POOL_P = (size_t)M * D;
constexpr size_t O_POOL_S = O_POOL_P + (size_t)4 * 4 * 15 * 1024;
constexpr size_t O_K_P = O_POOL_S + (size_t)4 * 32 * 15 * 1024;
constexpr size_t O_K_S = O_K_P + (size_t)4 * 4 * 128 * 256;
constexpr size_t O_V_P = O_K_S + (size_t)4 * 32 * 128 * 256;
constexpr size_t O_V_S = O_V_P + (size_t)4 * 4 * 128 * 256;
constexpr size_t O_CONV_P = O_V_S + (size_t)4 * 32 * 128 * 256;
constexpr size_t O_CONV_S = O_CONV_P + (size_t)4 * 4 * 3 * 1024;
constexpr size_t O_H_P = O_CONV_S + (size_t)4 * 32 * 3 * 1024;
constexpr size_t O_H_S = O_H_P + (size_t)4 * 4 * 1024;
constexpr size_t O_END = O_H_S + (size_t)4 * 32 * 1024;

constexpr size_t MiB = 1u << 20;
constexpr size_t WS_CTL = 0, CTL_BYTES = 2 * MiB;
constexpr int CW_TMO = 0, CW_BAR = 4096, CW_SS = 16384;
constexpr size_t WS_LRUG = 1 * MiB;
constexpr size_t WS_ROPE = 2 * MiB;
constexpr size_t WS_TBL = 2 * MiB + 512 * 1024;
constexpr size_t WS_SUMM = 3 * MiB;
constexpr size_t WS_PP = 4 * MiB;
constexpr size_t WS_GATE = 6 * MiB;
constexpr size_t WS_WBPT = 8 * MiB;
constexpr size_t WS_W = 24 * MiB;
constexpr size_t LW_GUA = 0, LW_DNA = 44 * MiB, LW_IN = 66 * MiB, LW_CAT = 108 * MiB, LW_OUT = 120 * MiB, LW_GUB = 128 * MiB, LW_DNB = 172 * MiB, LW_STRIDE = 194 * MiB;
constexpr size_t WS_XB = WS_W + 4 * LW_STRIDE;
constexpr size_t WS_ACT = WS_XB + 33 * MiB;
constexpr size_t WS_Z = WS_ACT + 91 * MiB;
constexpr size_t WS_BR = WS_Z + 174 * MiB;
constexpr size_t WS_MRG = WS_BR + 50 * MiB;
constexpr size_t WS_MB = WS_MRG + 66 * MiB;
constexpr size_t WS_END = WS_MB + 33 * MiB;
static_assert((size_t)CW_SS * 4 + (size_t)13 * M * 8 <= CTL_BYTES, "ctl");
static_assert((size_t)M * D * 2 <= 33 * MiB && (size_t)M * FF * 2 <= 91 * MiB && (size_t)M * NIN * 2 <= 174 * MiB && (size_t)M * NBR * 2 <= 50 * MiB && (size_t)M * D * 4 <= 66 * MiB, "ws");
static_assert((size_t)NGU * D * 2 <= 44 * MiB && (size_t)D * FF * 2 <= 22 * MiB && (size_t)NIN * D * 2 <= 42 * MiB && (size_t)D * NBR * 2 <= 12 * MiB && (size_t)D * D * 2 <= 8 * MiB, "ws w");

constexpr int RING_BYTES = 131072;
constexpr int LDSCTL_OFF = RING_BYTES, MISC_OFF = LDSCTL_OFF + 320;
constexpr int LDS_BYTES = 147456;

typedef __bf16 bf16x2_t __attribute__((ext_vector_type(2)));
__device__ __forceinline__ unsigned cvt_pk_bf16(float lo, float hi) { const f32x2 v = {lo, hi}; return __builtin_bit_cast(unsigned, __builtin_convertvector(v, bf16x2_t)); }
__device__ __forceinline__ float bf_lo(unsigned w) { return __uint_as_float(w << 16); }
__device__ __forceinline__ float bf_hi(unsigned w) { return __uint_as_float(w & 0xffff0000u); }
__device__ __forceinline__ float bf1(bf16_t b) { return __uint_as_float(((unsigned)b) << 16); }
__device__ __forceinline__ bf16_t f2bf(float f) { return (bf16_t)(cvt_pk_bf16(f, 0.f) & 0xffffu); }
__device__ __forceinline__ float sigmoidf_(float x) { return __builtin_amdgcn_rcpf(1.0f + __expf(-x)); }
typedef unsigned u32x2v __attribute__((ext_vector_type(2)));
__device__ __forceinline__ float xsum_16_32(float x) {
    u32x2v r = __builtin_amdgcn_permlane16_swap(__float_as_uint(x), __float_as_uint(x), false, false); const float y = __uint_as_float(r[0]) + __uint_as_float(r[1]);
    u32x2v q = __builtin_amdgcn_permlane32_swap(__float_as_uint(y), __float_as_uint(y), false, false); return __uint_as_float(q[0]) + __uint_as_float(q[1]); }
__device__ __forceinline__ float xmax_16_32(float x) {
    u32x2v r = __builtin_amdgcn_permlane16_swap(__float_as_uint(x), __float_as_uint(x), false, false); const float y = fmaxf(__uint_as_float(r[0]), __uint_as_float(r[1]));
    u32x2v q = __builtin_amdgcn_permlane32_swap(__float_as_uint(y), __float_as_uint(y), false, false); return fmaxf(__uint_as_float(q[0]), __uint_as_float(q[1])); }
__device__ __forceinline__ float expm1_neg(float x) { const float p = x * (1.0f + x * (0.5f + x * (0.16666667f + x * (0.041666668f + x * (0.0083333338f + x * 0.0013888889f))))); return x > -0.35f ? p : __expf(x) - 1.0f; }
typedef unsigned long long u64;
__device__ __forceinline__ u64 ss_fix(float s) { return (u64)((double)s * 68719476736.0 + 0.5); }
__device__ __forceinline__ float rstd_of(unsigned hi) { return rsqrtf((float)hi * (1.0f / 16.0f / 2048.0f) + RMS_EPS); }
#define LDS_WAIT() asm volatile("s_waitcnt lgkmcnt(0)" ::: "memory")
#define VM_WAIT() asm volatile("s_waitcnt vmcnt(0)" ::: "memory")

namespace pg8 {
constexpr int BM = 256, BK = 64, HALF = 128, HTB = HALF * BK * 2, STAGE_BYTES = 8 * HTB, NXCD = 8, WGM = 8;
__device__ __forceinline__ int lds_byte(int r, int c) { const int st = (r >> 4) * 2 + (c >> 5), rr = r & 15, cc = c & 31, ob = rr * 64 + cc * 2; return st * 1024 + (ob ^ (((ob >> 9) & 1) << 5)); }
__device__ __forceinline__ void stage_rc(int b, int& R, int& C) { const int st = b / 1024, sb = b % 1024, swz = sb ^ (((sb >> 9) & 1) << 5); R = (st >> 1) * 16 + swz / 64; C = (st & 1) * 32 + (swz % 64) / 2; }
__device__ __forceinline__ int perm32(int rho) { const int n = rho >> 4, i = rho & 15; return 8 * (i >> 2) + 4 * n + (i & 3); }

struct Unit { int pm, pn, pz, xrow; long aoff, boff, xoff; };
struct Gemm { const bf16_t* A; const bf16_t* Bt; int lda, ldb, K; };

struct OrderStd {
    int nM, nN, nZ, nwg, G, c; long aM, aZ, bN, bZ;
    __device__ __forceinline__ void init(int nM_, int nN_, int nZ_, int G_, int c_, long lda, long ldb, long aZ_, long bZ_) {
        nM = nM_; nN = nN_; nZ = nZ_; nwg = nM * nN; G = G_; c = c_; aM = 256 * lda; bN = 256 * ldb; aZ = aZ_; bZ = bZ_; }
    __device__ __forceinline__ bool next(int i, Unit& u) const {
        const int j = i / nZ, z = i - j * nZ;
        const long L = (long)j * G + c; if (L >= nwg) return false;
        int wgid = (int)L; { const int q = nwg / NXCD, r = nwg % NXCD, xcd = wgid % NXCD, off = wgid / NXCD; wgid = (xcd < r ? xcd * (q + 1) : r * (q + 1) + (xcd - r) * q) + off; }
        const int nig = WGM * nN, gid = wgid / nig, fm = gid * WGM, gsz = (nM - fm) < WGM ? (nM - fm) : WGM;
        u.pm = fm + ((wgid % nig) % gsz); u.pn = (wgid % nig) / gsz; u.pz = z;
        u.aoff = (long)u.pm * aM + (long)z * aZ; u.boff = (long)u.pn * bN + (long)z * bZ; u.xrow = -1; u.xoff = u.aoff; return true;
    }
};
struct OrderRide {
    OrderStd o; long lda;
    __device__ __forceinline__ void init(int G_, int c_, long lda_, long ldb) { o.init(MP / 256, D / 256, 1, G_, c_, lda_, ldb, 0, 0); lda = lda_; }
    __device__ __forceinline__ bool next(int i, Unit& u) const { if (!o.next(i, u)) return false; if (u.pm < 16) { u.xrow = MP + 16 * u.pm; u.xoff = (long)u.xrow * lda; } return true; }
};
struct OrderWeff {
    int G, c;
    __device__ __forceinline__ bool next(int i, Unit& u) const {
        const int L = i * G + c; if (L >= 128) return false;
        const int layer = L >> 5, g = (L >> 3) & 3, pm = L & 7;
        u.pm = pm; u.pn = 0; u.pz = layer * 4 + g;
        u.aoff = (long)layer * 2048 * 1024 + (long)g * 256 + (long)pm * 256 * 1024; u.boff = (long)(layer * 4 + g) * 65536; u.xrow = -1; u.xoff = u.aoff; return true;
    }
};

struct EpiGU {
    static constexpr bool PERM = true, HOOK = false, PRE = true;
    bf16_t* act; const u64* ss;
    __device__ __forceinline__ void pre(const Unit& u, int wr, int fr, unsigned (&rq)[8]) const {
#pragma unroll
        for (int i = 0; i < 8; ++i) rq[i] = ((const unsigned*)ss)[2 * (u.pm * BM + wr * 64 + fr + (i >> 2) * HALF + (i & 3) * 16) + 1]; }
    __device__ __forceinline__ void operator()(const f32x4 (&acc)[2][2][4][2], const Unit& u, int wr, int wc, int fr, int fq, const unsigned (&rq)[8]) const {
        const int row0 = u.pm * BM + wr * 64 + fr, col = u.pn * 128 + wc * 32 + 8 * fq;
#pragma unroll
        for (int ai = 0; ai < 2; ++ai)
#pragma unroll
            for (int m = 0; m < 4; ++m) { const int row = row0 + ai * HALF + m * 16; const float rs = rstd_of(rq[ai * 4 + m]);
                float o[8];
#pragma unroll
                for (int n = 0; n < 2; ++n)
#pragma unroll
                    for (int j = 0; j < 4; ++j) { const float g = acc[ai][0][m][n][j] * rs, uu = acc[ai][1][m][n][j] * rs; o[n * 4 + j] = g * sigmoidf_(g) * uu; }
                u32x4 w; w.x = cvt_pk_bf16(o[0], o[1]); w.y = cvt_pk_bf16(o[2], o[3]); w.z = cvt_pk_bf16(o[4], o[5]); w.w = cvt_pk_bf16(o[6], o[7]);
                *(u32x4*)(act + (size_t)row * FF + col) = w; }
    }
};
struct EpiIn {
    static constexpr bool PERM = true, HOOK = false, PRE = true;
    bf16_t* Z; const u64* ss;
    __device__ __forceinline__ void pre(const Unit& u, int wr, int fr, unsigned (&rq)[8]) const {
#pragma unroll
        for (int i = 0; i < 8; ++i) rq[i] = ((const unsigned*)ss)[2 * (u.pm * BM + wr * 64 + fr + (i >> 2) * HALF + (i & 3) * 16) + 1]; }
    __device__ __forceinline__ void operator()(const f32x4 (&acc)[2][2][4][2], const Unit& u, int wr, int wc, int fr, int fq, const unsigned (&rq)[8]) const {
        const int row0 = u.pm * BM + wr * 64 + fr, col = u.pn * BM + wc * 32 + 8 * fq; const bool sig = u.pn >= 18;
#pragma unroll
        for (int ai = 0; ai < 2; ++ai)
#pragma unroll
            for (int m = 0; m < 4; ++m) { const int row = row0 + ai * HALF + m * 16; const float rs = rstd_of(rq[ai * 4 + m]);
#pragma unroll
                for (int bj = 0; bj < 2; ++bj) { float o[8];
#pragma unroll
                    for (int n = 0; n < 2; ++n)
#pragma unroll
                        for (int j = 0; j < 4; ++j) { float v = acc[ai][bj][m][n][j] * rs; if (sig) v = sigmoidf_(v); o[n * 4 + j] = v; }
                    u32x4 w; w.x = cvt_pk_bf16(o[0], o[1]); w.y = cvt_pk_bf16(o[2], o[3]); w.z = cvt_pk_bf16(o[4], o[5]); w.w = cvt_pk_bf16(o[6], o[7]);
                    *(u32x4*)(Z + (size_t)row * NIN + col + bj * HALF) = w; } }
    }
};
struct EpiRes {
    static constexpr bool PERM = true, HOOK = false, PRE = false;
    __device__ __forceinline__ void pre(const Unit&, int, int, unsigned (&)[8]) const {}
    float* Y; bf16_t* XB; u64* ssn; float scale;
    __device__ __forceinline__ float one8(const f32x4 a0, const f32x4 a1, unsigned off) const {
        const u32x4 xw = *(const u32x4*)(XB + off); f32x4 x0, x1;
        x0[0] = bf_lo(xw.x); x0[1] = bf_hi(xw.x); x0[2] = bf_lo(xw.y); x0[3] = bf_hi(xw.y); x1[0] = bf_lo(xw.z); x1[1] = bf_hi(xw.z); x1[2] = bf_lo(xw.w); x1[3] = bf_hi(xw.w);
        x0 = x0 + a0 * scale; x1 = x1 + a1 * scale; if (Y) { *(f32x4*)(Y + off) = x0; *(f32x4*)(Y + off + 4) = x1; }
        u32x4 w; w.x = cvt_pk_bf16(x0[0], x0[1]); w.y = cvt_pk_bf16(x0[2], x0[3]); w.z = cvt_pk_bf16(x1[0], x1[1]); w.w = cvt_pk_bf16(x1[2], x1[3]); *(u32x4*)(XB + off) = w;
        const float r0 = bf_lo(w.x), r1 = bf_hi(w.x), r2 = bf_lo(w.y), r3 = bf_hi(w.y), r4 = bf_lo(w.z), r5 = bf_hi(w.z), r6 = bf_lo(w.w), r7 = bf_hi(w.w);
        return ((r0 * r0 + r1 * r1) + (r2 * r2 + r3 * r3)) + ((r4 * r4 + r5 * r5) + (r6 * r6 + r7 * r7)); }
    __device__ __forceinline__ void operator()(const f32x4 (&acc)[2][2][4][2], const Unit& u, int wr, int wc, int fr, int fq, const unsigned (&)[8]) const {
        const int row0 = u.pm * BM + wr * 64 + fr, col0 = u.pn * BM + wc * 32 + 8 * fq;
#pragma unroll
        for (int ai = 0; ai < 2; ++ai)
#pragma unroll
            for (int mp = 0; mp < 2; ++mp) { const int rowa = row0 + ai * HALF + (2 * mp) * 16, rowb = rowa + 16; float sa = 0.f, sb = 0.f;
#pragma unroll
                for (int bj = 0; bj < 2; ++bj) sa += one8(acc[ai][bj][2 * mp][0], acc[ai][bj][2 * mp][1], (unsigned)rowa * (unsigned)D + (unsigned)(col0 + bj * HALF));
#pragma unroll
                for (int bj = 0; bj < 2; ++bj) sb += one8(acc[ai][bj][2 * mp + 1][0], acc[ai][bj][2 * mp + 1][1], (unsigned)rowb * (unsigned)D + (unsigned)(col0 + bj * HALF));
                u32x2v p = __builtin_amdgcn_permlane16_swap(__float_as_uint(sa), __float_as_uint(sb), false, false);
                const float t = __uint_as_float(p[0]) + __uint_as_float(p[1]);
                u32x2v q = __builtin_amdgcn_permlane32_swap(__float_as_uint(t), __float_as_uint(t), false, false);
                const float tot = __uint_as_float(q[0]) + __uint_as_float(q[1]);
                if (fq < 2) atomicAdd(ssn + (fq == 0 ? rowa : rowb), ss_fix(tot));
                asm volatile("" ::: "memory"); }
    }
    __device__ __forceinline__ void extra(const f32x4 (&accx)[2], const Unit& u, int wr, int wc, int fr, int fq) const {
        const int row = u.xrow + fr; float s = one8(accx[0], accx[1], (unsigned)row * (unsigned)D + (unsigned)(u.pn * BM + wr * HALF + wc * 32 + 8 * fq));
        s += __shfl_xor(s, 16); s += __shfl_xor(s, 32);
        if (fq == 0) atomicAdd(ssn + row, ss_fix(s));
    }
};
struct EpiBr {
    static constexpr bool PERM = true, HOOK = true, PRE = false;
    __device__ __forceinline__ void pre(const Unit&, int, int, unsigned (&)[8]) const {}
    const bf16_t* Z; bf16_t* MB;
    __device__ __forceinline__ void gate8(int row, int col, int z, f32x4& g0, f32x4& g1) const {
        const unsigned idx = (unsigned)row * (unsigned)NIN + (unsigned)(ZC_G + D * z + col); const u32x4 gw = *(const u32x4*)(Z + idx);
        g0[0] = bf_lo(gw.x); g0[1] = bf_hi(gw.x); g0[2] = bf_lo(gw.y); g0[3] = bf_hi(gw.y); g1[0] = bf_lo(gw.z); g1[1] = bf_hi(gw.z); g1[2] = bf_lo(gw.w); g1[3] = bf_hi(gw.w); }
    __device__ __forceinline__ void ratio8(int row, int col, int z, f32x4& r0, f32x4& r1) const {
        f32x4 a0, a1, b0, b1; gate8(row, col, z, a0, a1); gate8(row, col, z + 1, b0, b1);
#pragma unroll
        for (int j = 0; j < 4; ++j) { r0[j] = a0[j] * __builtin_amdgcn_rcpf(fmaxf(b0[j], 5.9604645e-08f)); r1[j] = a1[j] * __builtin_amdgcn_rcpf(fmaxf(b1[j], 5.9604645e-08f)); } }
    __device__ __forceinline__ bool hook_at(int t) const { return t == 16 || t == 32; }
    __device__ __forceinline__ void mid(f32x4 (&acc)[2][2][4][2], f32x4 (&accx)[2], const Unit& u, int t, int wr, int wc, int fr, int fq) const {
        const int z = (t >> 4) - 1, row0 = u.pm * BM + wr * 64 + fr, col0 = u.pn * BM + wc * 32 + 8 * fq;
#pragma unroll
        for (int ai = 0; ai < 2; ++ai) {
#pragma unroll
            for (int m = 0; m < 4; ++m) { const int row = row0 + ai * HALF + m * 16;
#pragma unroll
                for (int bj = 0; bj < 2; ++bj) { f32x4 r0, r1; ratio8(row, col0 + bj * HALF, z, r0, r1); acc[ai][bj][m][0] = acc[ai][bj][m][0] * r0; acc[ai][bj][m][1] = acc[ai][bj][m][1] * r1; }
                if (m & 1) asm volatile("" : "+v"(acc[ai][0][m - 1][0]), "+v"(acc[ai][0][m - 1][1]), "+v"(acc[ai][1][m - 1][0]), "+v"(acc[ai][1][m - 1][1]), "+v"(acc[ai][0][m][0]), "+v"(acc[ai][0][m][1]), "+v"(acc[ai][1][m][0]), "+v"(acc[ai][1][m][1]) :: "memory"); } }
        if (u.xrow >= 0) { f32x4 r0, r1; ratio8(u.xrow + fr, u.pn * BM + wr * HALF + wc * 32 + 8 * fq, z, r0, r1); accx[0] = accx[0] * r0; accx[1] = accx[1] * r1; }
    }
    __device__ __forceinline__ void put8(int row, int col, const f32x4 a0, const f32x4 a1) const {
        f32x4 g0, g1; gate8(row, col, 2, g0, g1); const f32x4 v0 = g0 * a0, v1 = g1 * a1;
        u32x4 w; w.x = cvt_pk_bf16(v0[0], v0[1]); w.y = cvt_pk_bf16(v0[2], v0[3]); w.z = cvt_pk_bf16(v1[0], v1[1]); w.w = cvt_pk_bf16(v1[2], v1[3]);
        *(u32x4*)(MB + ((unsigned)row * (unsigned)D + (unsigned)col)) = w; }
    __device__ __forceinline__ void operator()(const f32x4 (&acc)[2][2][4][2], const Unit& u, int wr, int wc, int fr, int fq, const unsigned (&)[8]) const {
        const int row0 = u.pm * BM + wr * 64 + fr, col0 = u.pn * BM + wc * 32 + 8 * fq;
#pragma unroll
        for (int ai = 0; ai < 2; ++ai)
#pragma unroll
            for (int m = 0; m < 4; ++m) { const int row = row0 + ai * HALF + m * 16;
#pragma unroll
                for (int bj = 0; bj < 2; ++bj) put8(row, col0 + bj * HALF, acc[ai][bj][m][0], acc[ai][bj][m][1]);
                asm volatile("" ::: "memory"); }
    }
    __device__ __forceinline__ void extra(const f32x4 (&accx)[2], const Unit& u, int wr, int wc, int fr, int fq) const {
        put8(u.xrow + fr, u.pn * BM + wr * HALF + wc * 32 + 8 * fq, accx[0], accx[1]);
    }
};
struct EpiWeff {
    static constexpr bool PERM = true, HOOK = false, PRE = false;
    __device__ __forceinline__ void pre(const Unit&, int, int, unsigned (&)[8]) const {}
    bf16_t* WS;
    __device__ __forceinline__ void operator()(const f32x4 (&acc)[2][2][4][2], const Unit& u, int wr, int wc, int fr, int fq, const unsigned (&)[8]) const {
        const int layer = u.pz >> 2, g = u.pz & 3;
        bf16_t* O = (bf16_t*)((char*)WS + (size_t)layer * LW_STRIDE) + g * 256;
        const int row0 = u.pm * BM + wr * 64 + fr, col = wc * 32 + 8 * fq;
#pragma unroll
        for (int ai = 0; ai < 2; ++ai)
#pragma unroll
            for (int m = 0; m < 4; ++m) { const int row = row0 + ai * HALF + m * 16;
#pragma unroll
                for (int bj = 0; bj < 2; ++bj) { const f32x4 v0 = acc[ai][bj][m][0], v1 = acc[ai][bj][m][1];
                    u32x4 w; w.x = cvt_pk_bf16(v0[0], v0[1]); w.y = cvt_pk_bf16(v0[2], v0[3]); w.z = cvt_pk_bf16(v1[0], v1[1]); w.w = cvt_pk_bf16(v1[2], v1[3]);
                    *(u32x4*)(O + (size_t)row * NBR + col + bj * HALF) = w; } }
    }
};

constexpr int XOFF = RING_BYTES + 2048;
template <bool XR, class Epi, class Sched>
__device__ __forceinline__ void gemm_phase(LAS unsigned char* lds, const Gemm g, const Sched& S, const Epi& E) {
    int tid = threadIdx.x; asm volatile("" : "+v"(tid));
    const int wid = __builtin_amdgcn_readfirstlane(tid >> 6), lane = tid & 63, wr = wid >> 2, wc = wid & 3, fr = lane & 15, fq = lane >> 4;
    int nt = g.K / BK; asm volatile("" : "+s"(nt));
    unsigned voffA, voffB, voffX = 0;
    { int R, C; stage_rc(tid * 16, R, C); const int Rb = Epi::PERM ? ((R & ~31) + perm32(R & 31)) : R;
      voffA = (unsigned)(R * g.lda + C) * 2u; voffB = (unsigned)(Rb * g.ldb + C) * 2u; }
    const size_t r64A = (size_t)64 * g.lda * 2, r64B = (size_t)64 * g.ldb * 2;
    if (XR) { int R, C; stage_rc(tid * 4, R, C); voffX = (unsigned)(R * g.lda + C) * 2u; }
    const size_t kstep = (size_t)(BK * 2);
    const size_t hstepA = (size_t)HALF * g.lda * 2, hstepB = (size_t)HALF * g.ldb * 2;
    const unsigned ldsw = (unsigned)wid * 1024u;
    const int aoff = lds_byte(wr * 64 + fr, fq * 8), boff = lds_byte(wc * 32 + fr, fq * 8), xoffr = lds_byte(fr, fq * 8);
#define PG8_SA(b, h) (((b) * 2 + (h)) * HTB)
#define PG8_SB(b, h) ((4 + (b) * 2 + (h)) * HTB)
#define PG8_STAGE(bufoff, gbase, voff) do { _Pragma("unroll") for (int _i = 0; _i < 2; ++_i) \
        __builtin_amdgcn_global_load_lds((const unsigned*)((const char*)(gbase) + (_i ? PG8_R64_##voff : (size_t)0) + (voff)), (LAS unsigned*)(lds + (bufoff) + ldsw + _i * 8192), 16, 0, 0); } while (0)
#define PG8_R64_voffA r64A
#define PG8_R64_voffB r64B
#define PG8_STAGEX(b, gbase) do { if (XR) __builtin_amdgcn_global_load_lds((const unsigned*)((const char*)(gbase) + voffX), (LAS unsigned*)(lds + XOFF + (b) * 2048 + (unsigned)wid * 256u), 4, 0, 0); } while (0)
#define PG8_LDA(dst, b, h) do { _Pragma("unroll") for (int m = 0; m < 4; ++m) _Pragma("unroll") for (int k = 0; k < 2; ++k) dst[m][k] = *(const LAS bf16x8*)(lds + PG8_SA(b, h) + aoff + m * 2048 + k * 1024); } while (0)
#define PG8_LDB(dst, b, h) do { _Pragma("unroll") for (int n = 0; n < 2; ++n) _Pragma("unroll") for (int k = 0; k < 2; ++k) dst[n][k] = *(const LAS bf16x8*)(lds + PG8_SB(b, h) + boff + n * 2048 + k * 1024); } while (0)
#define PG8_LDX(b) do { if (XR && hasx) { _Pragma("unroll") for (int k = 0; k < 2; ++k) Ax[k] = *(const LAS bf16x8*)(lds + XOFF + (b) * 2048 + xoffr + k * 1024); } } while (0)
#define PG8_MMA(ai, bj, At, Bt) do { __builtin_amdgcn_s_setprio(1); _Pragma("unroll") for (int m = 0; m < 4; ++m) _Pragma("unroll") for (int n = 0; n < 2; ++n) _Pragma("unroll") for (int k = 0; k < 2; ++k) \
        acc[ai][bj][m][n] = __builtin_amdgcn_mfma_f32_16x16x32_bf16(Bt[n][k], At[m][k], acc[ai][bj][m][n], 0, 0, 0); __builtin_amdgcn_s_setprio(0); } while (0)
#define PG8_MMAX() do { if (XR && hasx) { if (wr == 0) { _Pragma("unroll") for (int n = 0; n < 2; ++n) _Pragma("unroll") for (int k = 0; k < 2; ++k) accx[n] = __builtin_amdgcn_mfma_f32_16x16x32_bf16(B0[n][k], Ax[k], accx[n], 0, 0, 0); } \
        else { _Pragma("unroll") for (int n = 0; n < 2; ++n) _Pragma("unroll") for (int k = 0; k < 2; ++k) accx[n] = __builtin_amdgcn_mfma_f32_16x16x32_bf16(B1[n][k], Ax[k], accx[n], 0, 0, 0); } } } while (0)
#define PG8_WAIT_V(n) asm volatile("s_waitcnt vmcnt(" #n ")" ::: "memory")
#define PG8_WAIT_VL() do { if (XR) PG8_WAIT_V(9); else PG8_WAIT_V(8); } while (0)
#define PG8_WAIT_L(n) asm volatile("s_waitcnt lgkmcnt(" #n ")" ::: "memory")
#define PG8_BAR __builtin_amdgcn_s_barrier()
#define PG8_SCHED __builtin_amdgcn_sched_barrier(0)
    Unit cur, nxt; int ui = 0;
    if (!S.next(0, cur)) return;
    f32x4 acc[2][2][4][2], accx[2];
#pragma unroll
    for (int a = 0; a < 2; ++a)
#pragma unroll
        for (int b = 0; b < 2; ++b)
#pragma unroll
            for (int m = 0; m < 4; ++m)
#pragma unroll
                for (int n = 0; n < 2; ++n) acc[a][b][m][n] = (f32x4){0.f, 0.f, 0.f, 0.f};
    accx[0] = (f32x4){0.f, 0.f, 0.f, 0.f}; accx[1] = (f32x4){0.f, 0.f, 0.f, 0.f};
    bf16x8 At[4][2], B0[2][2], B1[2][2], Ax[2]; unsigned rq[8] = {0, 0, 0, 0, 0, 0, 0, 0};
    const char* cA = (const char*)(g.A + cur.aoff); const char* cB = (const char*)(g.Bt + cur.boff); const char* cX = (const char*)(g.A + cur.xoff);
    PG8_STAGE(PG8_SB(0, 0), cB, voffB); PG8_STAGE(PG8_SB(0, 1), cB + hstepB, voffB); PG8_STAGE(PG8_SA(0, 0), cA, voffA); PG8_STAGEX(0, cX); PG8_STAGE(PG8_SA(0, 1), cA + hstepA, voffA);
    if (wr == 1) PG8_BAR;
    PG8_WAIT_V(2); PG8_BAR;
    PG8_STAGE(PG8_SB(1, 0), cB + kstep, voffB); PG8_STAGE(PG8_SA(1, 0), cA + kstep, voffA); PG8_STAGE(PG8_SB(1, 1), cB + hstepB + kstep, voffB); PG8_STAGEX(1, cX + kstep);
    if (XR) PG8_WAIT_V(7); else PG8_WAIT_V(6);
    PG8_BAR;
    for (;;) {
        const bool has_next = S.next(ui + 1, nxt);
        const char* nA = has_next ? (const char*)(g.A + nxt.aoff) : cA; const char* nB = has_next ? (const char*)(g.Bt + nxt.boff) : cB; const char* nX = has_next ? (const char*)(g.A + nxt.xoff) : cX;
        const bool hasx = XR && cur.xrow >= 0;
        for (int t = 0; t < nt; t += 2) {
            const bool last = (t == nt - 2);
            const char* a1 = cA + (size_t)(t + 1) * kstep;
            const char* a2 = last ? nA : cA + (size_t)(t + 2) * kstep; const char* b2 = last ? nB : cB + (size_t)(t + 2) * kstep; const char* x2 = last ? nX : cX + (size_t)(t + 2) * kstep;
            const char* a3 = a2 + kstep; const char* b3 = b2 + kstep; const char* x3 = x2 + kstep;
            if constexpr (Epi::PRE) { if (last) { int tz = threadIdx.x; asm volatile("" : "+v"(tz)); const int wz = __builtin_amdgcn_readfirstlane(tz >> 6); E.pre(cur, wz >> 2, tz & 15, rq); } }
            if constexpr (Epi::HOOK) { if (E.hook_at(t)) { int tz = threadIdx.x; asm volatile("" : "+v"(tz));
                const int wz = __builtin_amdgcn_readfirstlane(tz >> 6); E.mid(acc, accx, cur, t, wz >> 2, wz & 3, tz & 15, (tz & 63) >> 4); } }
            PG8_LDB(B0, 0, 0); PG8_LDB(B1, 0, 1); PG8_SCHED; PG8_LDA(At, 0, 0); PG8_LDX(0); PG8_STAGE(PG8_SA(1, 1), a1 + hstepA, voffA);
            PG8_WAIT_VL(); PG8_WAIT_L(0); PG8_BAR; PG8_MMA(0, 0, At, B0); PG8_MMA(0, 1, At, B1); PG8_MMAX(); PG8_BAR; PG8_SCHED;
            PG8_LDA(At, 0, 1); PG8_STAGE(PG8_SB(0, 0), b2, voffB); PG8_STAGE(PG8_SB(0, 1), b2 + hstepB, voffB); PG8_STAGE(PG8_SA(0, 0), a2, voffA); PG8_STAGEX(0, x2);
            PG8_WAIT_VL(); PG8_WAIT_L(0); PG8_BAR; PG8_MMA(1, 0, At, B0); PG8_MMA(1, 1, At, B1); PG8_BAR; PG8_SCHED;
            PG8_LDB(B0, 1, 0); PG8_LDB(B1, 1, 1); PG8_SCHED; PG8_LDA(At, 1, 0); PG8_LDX(1); PG8_STAGE(PG8_SA(0, 1), a2 + hstepA, voffA);
            PG8_WAIT_VL(); PG8_WAIT_L(0); PG8_BAR; PG8_MMA(0, 0, At, B0); PG8_MMA(0, 1, At, B1); PG8_MMAX(); PG8_BAR; PG8_SCHED;
            PG8_LDA(At, 1, 1); PG8_STAGE(PG8_SB(1, 0), b3, voffB); PG8_STAGE(PG8_SB(1, 1), b3 + hstepB, voffB); PG8_STAGE(PG8_SA(1, 0), a3, voffA); PG8_STAGEX(1, x3);
            PG8_WAIT_VL(); PG8_WAIT_L(0); PG8_BAR; PG8_MMA(1, 0, At, B0); PG8_MMA(1, 1, At, B1); PG8_BAR; PG8_SCHED;
        }
        if (wr == 0) PG8_BAR;
        { int tz = threadIdx.x; asm volatile("" : "+v"(tz)); const int wz = __builtin_amdgcn_readfirstlane(tz >> 6), ewr = wz >> 2, ewc = wz & 3, efr = tz & 15, efq = (tz & 63) >> 4;
          E(acc, cur, ewr, ewc, efr, efq, rq);
          if constexpr (XR) { if (cur.xrow >= 0) E.extra(accx, cur, ewr, ewc, efr, efq); } }
        if (!has_next) break;
#pragma unroll
        for (int a = 0; a < 2; ++a)
#pragma unroll
            for (int b = 0; b < 2; ++b)
#pragma unroll
                for (int m = 0; m < 4; ++m)
#pragma unroll
                    for (int n = 0; n < 2; ++n) acc[a][b][m][n] = (f32x4){0.f, 0.f, 0.f, 0.f};
        accx[0] = (f32x4){0.f, 0.f, 0.f, 0.f}; accx[1] = (f32x4){0.f, 0.f, 0.f, 0.f};
        cur = nxt; cA = nA; cB = nB; cX = nX; ++ui;
        if (wr == 1) PG8_BAR;
    }
    PG8_WAIT_V(0);
    PG8_BAR;
#undef PG8_SA
#undef PG8_SB
#undef PG8_STAGE
#undef PG8_R64_voffA
#undef PG8_R64_voffB
#undef PG8_STAGEX
#undef PG8_LDA
#undef PG8_LDB
#undef PG8_LDX
#undef PG8_MMA
#undef PG8_MMAX
#undef PG8_WAIT_V
#undef PG8_WAIT_VL
#undef PG8_WAIT_L
#undef PG8_BAR
#undef PG8_SCHED
}
}

#define XB_TMO      128
#define XB_XCNT(j)  (256  + 64 * (j))
#define XB_XSUB(j)  (1280 + 64 * (j))
#define XB_XGEN(j)  (2304 + 64 * (j))
#define XB_TOP      3328
#define XB_TOPGEN   3392
#define XCD_BAR_WORDS 3456
#define XB_SPIN_CAP (1u << 18)
__device__ __forceinline__ unsigned xb_ld(unsigned* p)              { return __hip_atomic_load(p, __ATOMIC_RELAXED, __HIP_MEMORY_SCOPE_AGENT); }
__device__ __forceinline__ unsigned xb_add(unsigned* p, unsigned v) { return __hip_atomic_fetch_add(p, v, __ATOMIC_RELAXED, __HIP_MEMORY_SCOPE_AGENT); }
__device__ __forceinline__ unsigned xb_xcc_id() { return (unsigned)__builtin_amdgcn_s_getreg((3 << 11) | 20) & 0xFu; }
#define XB_SPIN(cond, bar) do { unsigned _sp = 0; while (cond) { __builtin_amdgcn_s_sleep(1); \
    if ((++_sp & 255u) == 0u) { if (xb_ld(&(bar)[XB_TMO])) break; if (_sp > XB_SPIN_CAP) { atomicAdd(&(bar)[XB_TMO], 1u); break; } } } } while (0)
struct XcdBarrier { unsigned* bar; unsigned x; volatile LAS unsigned* st; };
__device__ __forceinline__ XcdBarrier xcd_barrier_post(unsigned* bar, volatile LAS unsigned* st) {
    XcdBarrier b; b.bar = bar; b.x = xb_xcc_id(); b.st = st;
    if (threadIdx.x == 0) (void)xb_add(&bar[XB_XCNT(b.x)], 1u);
    return b;
}
__device__ __forceinline__ void xcd_barrier_complete(unsigned* bar, unsigned x, unsigned& nloc, unsigned& nx) {
    const unsigned G = gridDim.x * gridDim.y * gridDim.z;
    unsigned sum, cnt, mine, sp = 0u;
    for (;;) {
        sum = 0u; cnt = 0u; mine = 0u;
#pragma unroll
        for (unsigned j = 0; j < 16; ++j) { const unsigned c = xb_ld(&bar[XB_XCNT(j)]); sum += c; cnt += (c > 0u) ? 1u : 0u; mine = (j == x) ? c : mine; }
        if (sum == G) break;
        __builtin_amdgcn_s_sleep(1);
        if ((++sp & 255u) == 0u) { if (xb_ld(&bar[XB_TMO])) break; if (sp > XB_SPIN_CAP) { atomicAdd(&bar[XB_TMO], 1u); break; } }
    }
    nloc = mine > 0u ? mine : 1u; nx = cnt > 0u ? cnt : 1u;
}
__device__ __forceinline__ void xcd_barrier(const XcdBarrier& b) {
    asm volatile("s_waitcnt vmcnt(0)" ::: "memory");
    __syncthreads();
    if (threadIdx.x == 0) {
        unsigned* bar = b.bar;
        __builtin_amdgcn_s_waitcnt(0);
        unsigned nloc = b.st[0], nx = b.st[1];
        if (nloc == 0u) { xcd_barrier_complete(bar, b.x, nloc, nx); b.st[0] = nloc; b.st[1] = nx; }
        const unsigned old = xb_add(&bar[XB_XSUB(b.x)], 1u);
        const unsigned gen = old / nloc;
        if (old + 1u == (gen + 1u) * nloc) {
            __builtin_amdgcn_fence(__ATOMIC_RELEASE, "agent");
            asm volatile("s_waitcnt vmcnt(0)" ::: "memory");
            const unsigned og = xb_add(&bar[XB_TOP], 1u);
            const unsigned tg = og / nx;
            if (og + 1u == (tg + 1u) * nx) xb_add(&bar[XB_TOPGEN], 1u);
            else XB_SPIN(xb_ld(&bar[XB_TOPGEN]) == tg, bar);
            __builtin_amdgcn_fence(__ATOMIC_ACQUIRE, "agent");
            xb_add(&bar[XB_XGEN(b.x)], 1u);
            asm volatile("s_waitcnt vmcnt(0)" ::: "memory");
        } else {
            XB_SPIN(xb_ld(&bar[XB_XGEN(b.x)]) == gen, bar);
            __builtin_amdgcn_fence(__ATOMIC_ACQUIRE, "agent");
            asm volatile("s_waitcnt vmcnt(0)" ::: "memory");
        }
    }
    __syncthreads();
}

struct Args { const float* in[31]; float* out; unsigned char* ws; int ph_lo, ph_hi; };
static_assert(sizeof(Args) == 31 * 8 + 8 + 8 + 8, "Args has no padding");

struct Ctx {
    const float* const* tbl; unsigned char* ws; float* out; int l;
    __device__ __forceinline__ const GAS float* in(int i) const { return (const GAS float*)tbl[i]; }
    __device__ __forceinline__ const bf16_t* Z() const { return (const bf16_t*)(ws + WS_Z); }
    __device__ __forceinline__ bf16_t* BR() const { return (bf16_t*)(ws + WS_BR); }
    __device__ __forceinline__ const float* rope() const { return (const float*)(ws + WS_ROPE); }
    __device__ __forceinline__ float* summ() const { return (float*)(ws + WS_SUMM); }
    __device__ __forceinline__ const GAS float* qn() const { return in(14) + l * 64; }
    __device__ __forceinline__ const GAS float* kn() const { return in(15) + l * 64; }
    __device__ __forceinline__ const GAS float* sinks() const { return in(16) + l * 16; }
    __device__ __forceinline__ const GAS float* cache_k() const { return in(3) + (size_t)l * 32 * 128 * 256; }
    __device__ __forceinline__ const GAS float* cache_v() const { return in(4) + (size_t)l * 32 * 128 * 256; }
    __device__ __forceinline__ const GAS float* state_pool() const { return in(2) + (size_t)l * 32 * 15 * 1024; }
    __device__ __forceinline__ const GAS float* state_conv() const { return in(5) + (size_t)l * 32 * 3 * 1024; }
    __device__ __forceinline__ const GAS float* state_h() const { return in(6) + (size_t)l * 32 * 1024; }
    __device__ __forceinline__ const GAS float* conv_w() const { return in(17) + l * 4096; }
    __device__ __forceinline__ const GAS float* conv_b() const { return in(18) + l * 1024; }
    __device__ __forceinline__ const GAS float* ba() const { return in(20) + l * 1024; }
    __device__ __forceinline__ const GAS float* bx() const { return in(22) + l * 1024; }
    __device__ __forceinline__ const GAS float* lam() const { return in(23) + l * 1024; }
    __device__ __forceinline__ const bf16_t* WaT() const { return (const bf16_t*)(ws + WS_GATE) + (size_t)(l * 2 + 0) * 65536; }
    __device__ __forceinline__ const bf16_t* WxT() const { return (const bf16_t*)(ws + WS_GATE) + (size_t)(l * 2 + 1) * 65536; }
    __device__ __forceinline__ float* o_pool(int sample) const { return out + (sample ? O_POOL_S + (size_t)l * 32 * 15 * 1024 : O_POOL_P + (size_t)l * 4 * 15 * 1024); }
    __device__ __forceinline__ float* o_k(int sample) const { return out + (sample ? O_K_S + (size_t)l * 32 * 128 * 256 : O_K_P + (size_t)l * 4 * 128 * 256); }
    __device__ __forceinline__ float* o_v(int sample) const { return out + (sample ? O_V_S + (size_t)l * 32 * 128 * 256 : O_V_P + (size_t)l * 4 * 128 * 256); }
    __device__ __forceinline__ float* o_conv(int sample) const { return out + (sample ? O_CONV_S + (size_t)l * 32 * 3 * 1024 : O_CONV_P + (size_t)l * 4 * 3 * 1024); }
    __device__ __forceinline__ float* o_h(int sample) const { return out + (sample ? O_H_S + (size_t)l * 32 * 1024 : O_H_P + (size_t)l * 4 * 1024); }
};

struct TDesc { const GAS float* src; const GAS float* gain; GAS bf16_t* dst; int ldw, ldo; };
__device__ __forceinline__ int gu_rowmap(int n0) { return n0 < FF ? 256 * (n0 >> 7) + (n0 & 127) : 256 * ((n0 - FF) >> 7) + 128 + ((n0 - FF) & 127); }
constexpr int TT_GU = (D / 64) * (NGU / 64), TT_DN = (FF / 64) * (D / 64), TT_IN = (D / 64) * (NIN / 64), TT_BR = (1024 / 64) * (D / 64), TT_OUT = (D / 64) * (D / 64), TT_GT = 32;
constexpr int TT_LAYER = 2 * TT_GU + 2 * TT_DN + TT_IN + 3 * TT_BR + TT_OUT + TT_GT;
struct PSArgs { const Args* a; __device__ __forceinline__ const float* operator()(int i) const { return a->in[i]; } };
struct PSTbl { const float* const* t; __device__ __forceinline__ const float* operator()(int i) const { return (const float*)(const GAS float*)t[i]; } };
constexpr int TT_STREAM = TT_LAYER - TT_BR, TT_B0 = DEPTH * TT_BR, TT_TOTAL = TT_B0 + DEPTH * TT_STREAM;
__host__ __device__ constexpr int tt_need(int l, int j) {
    int c = TT_GU; if (j >= 1) c += TT_DN; if (j >= 2) c += TT_IN; if (j >= 3) c += TT_GT + 2 * TT_BR; if (j >= 5) c += TT_OUT; if (j >= 6) c += TT_GU; if (j >= 7) c += TT_DN;
    return TT_B0 + l * TT_STREAM + c; }
static_assert(tt_need(DEPTH - 1, 7) == TT_TOTAL, "tile stream");
template <class PS>
__device__ __forceinline__ TDesc tr_decode(const PS& P, unsigned char* ws, int it) {
    TDesc d; d.gain = nullptr;
#define TT_SET(SRC, LDW, DST, LDO, OROW, OCOL, K0, N0) do { d.src = (const GAS float*)((SRC) + (size_t)(K0) * (LDW) + (N0)); d.ldw = (LDW); d.dst = (GAS bf16_t*)((DST) + (size_t)(OROW) * (LDO) + (OCOL) + (K0)); d.ldo = (LDO); } while (0)
    if (it < TT_B0) { const int l = it / TT_BR, r = it - l * TT_BR; const int kb = r / (D / 64), nb = r - kb * (D / 64);
        TT_SET(P(24) + (size_t)l * 1024 * D, D, (bf16_t*)(ws + WS_WBPT) + (size_t)l * D * 1024, 1024, 64 * nb, 0, 64 * kb, 64 * nb); return d; }
    it -= TT_B0;
    const int l = it / TT_STREAM; int r = it - l * TT_STREAM;
    unsigned char* lw = ws + WS_W + (size_t)l * LW_STRIDE;
    if (r < TT_GU) { const int kb = r / (NGU / 64), nb = r - kb * (NGU / 64); TT_SET(P(8) + (size_t)l * D * NGU, NGU, (bf16_t*)(lw + LW_GUA), D, gu_rowmap(64 * nb), 0, 64 * kb, 64 * nb); d.gain = (const GAS float*)(P(7) + l * D + 64 * kb); return d; } r -= TT_GU;
    if (r < TT_DN) { const int kb = r / (D / 64), nb = r - kb * (D / 64); TT_SET(P(9) + (size_t)l * FF * D, D, (bf16_t*)(lw + LW_DNA), FF, 64 * nb, 0, 64 * kb, 64 * nb); return d; } r -= TT_DN;
    if (r < TT_IN) { const int kb = r / (NIN / 64), nb = r - kb * (NIN / 64); TT_SET(P(11) + (size_t)l * D * NIN, NIN, (bf16_t*)(lw + LW_IN), D, 64 * nb, 0, 64 * kb, 64 * nb); d.gain = (const GAS float*)(P(10) + l * D + 64 * kb); return d; } r -= TT_IN;
    if (r < TT_GT) { const int gate = r >> 4, h = r & 15; TT_SET(P(gate ? 21 : 19) + (size_t)l * 65536 + h * 4096, 64, (bf16_t*)(ws + WS_GATE) + (size_t)((l * 2 + gate) * 16 + h) * 4096, 64, 0, 0, 0, 0); return d; } r -= TT_GT;
    if (r < TT_BR) { const int kb = r / (D / 64), nb = r - kb * (D / 64); TT_SET(P(25) + (size_t)l * 1024 * D, D, (bf16_t*)(lw + LW_CAT), NBR, 64 * nb, BRC_ATT, 64 * kb, 64 * nb); return d; } r -= TT_BR;
    if (r < TT_BR) { const int kb = r / (D / 64), nb = r - kb * (D / 64); TT_SET(P(26) + (size_t)l * 1024 * D, D, (bf16_t*)(lw + LW_CAT), NBR, 64 * nb, BRC_LRU, 64 * kb, 64 * nb); return d; } r -= TT_BR;
    if (r < TT_OUT) { const int kb = r / (D / 64), nb = r - kb * (D / 64); TT_SET(P(27) + (size_t)l * D * D, D, (bf16_t*)(lw + LW_OUT), D, 64 * nb, 0, 64 * kb, 64 * nb); return d; } r -= TT_OUT;
    if (r < TT_GU) { const int kb = r / (NGU / 64), nb = r - kb * (NGU / 64); TT_SET(P(29) + (size_t)l * D * NGU, NGU, (bf16_t*)(lw + LW_GUB), D, gu_rowmap(64 * nb), 0, 64 * kb, 64 * nb); d.gain = (const GAS float*)(P(28) + l * D + 64 * kb); return d; } r -= TT_GU;
    { const int kb = r / (D / 64), nb = r - kb * (D / 64); TT_SET(P(30) + (size_t)l * FF * D, D, (bf16_t*)(lw + LW_DNB), FF, 64 * nb, 0, 64 * kb, 64 * nb); }
#undef TT_SET
    return d;
}
__device__ __forceinline__ void tr_load(const TDesc& d, f32x4 (&v)[16], int lane) {
    const GAS float* p = d.src + (size_t)(2 * (lane >> 4)) * d.ldw + 4 * (lane & 15);
#pragma unroll
    for (int i = 0; i < 8; ++i) { v[2 * i] = *(const GAS f32x4*)(p + (size_t)(8 * i) * d.ldw); v[2 * i + 1] = *(const GAS f32x4*)(p + (size_t)(8 * i + 1) * d.ldw); }
}
__device__ __forceinline__ void tr_store(const TDesc& d, const f32x4 (&v)[16], LAS unsigned char* img, int lane) {
    const int n4 = lane & 15, kpl = lane >> 4;
#pragma unroll
    for (int i = 0; i < 8; ++i) { float g0 = 1.f, g1 = 1.f; if (d.gain) { g0 = d.gain[2 * (kpl + 4 * i)]; g1 = d.gain[2 * (kpl + 4 * i) + 1]; }
#pragma unroll
        for (int e = 0; e < 4; ++e) *(LAS unsigned*)(img + (4 * n4 + e) * 128 + ((i ^ (n4 & 7)) << 4) + kpl * 4) = cvt_pk_bf16(v[2 * i][e] * g0, v[2 * i + 1][e] * g1); }
    LDS_WAIT();
#pragma unroll
    for (int j = 0; j < 8; ++j) { const int idx = lane + 64 * j, n = idx >> 3, c = idx & 7;
        const u32x4 w = *(const LAS u32x4*)(img + n * 128 + ((c ^ ((n >> 2) & 7)) << 4));
        *(GAS u32x4*)(d.dst + (size_t)n * d.ldo + 8 * c) = w; }
    LDS_WAIT();
}


constexpr int CW_SPTR = 1024;
constexpr int TT_BASE0 = tt_need(0, 0);
template <class PS>
__device__ __forceinline__ void convert_range(const PS& P, unsigned char* ws, LAS unsigned char* img, int lane, int r0, int r1, int widx, int nw) {
    int it = r0 + widx; f32x4 va[16], vb[16]; TDesc da, db;
    if (it < r1) { da = tr_decode(P, ws, it); tr_load(da, va, lane); }
    while (it < r1) {
        const int it1 = it + nw; if (it1 < r1) { db = tr_decode(P, ws, it1); tr_load(db, vb, lane); }
        tr_store(da, va, img, lane);
        if (it1 >= r1) break;
        const int it2 = it1 + nw; if (it2 < r1) { da = tr_decode(P, ws, it2); tr_load(da, va, lane); }
        tr_store(db, vb, img, lane);
        it = it2; }
}
template <class PS>
__device__ __forceinline__ void convert_wg(const PS& P, unsigned char* ws, LAS unsigned char* lds, volatile LAS unsigned* st, unsigned* sp, int bound, int fixed) {
    int tz = threadIdx.x; asm volatile("" : "+v"(tz)); const int wz = __builtin_amdgcn_readfirstlane(tz >> 6), lz = tz & 63;
#pragma unroll 1
    for (;;) {
        if (tz == 0) { int base = -1, n = 0; const int cur = TT_BASE0 + (int)__hip_atomic_load(sp, __ATOMIC_RELAXED, __HIP_MEMORY_SCOPE_AGENT);
            if (cur < bound) { const int G_ = (int)gridDim.x; int want = fixed > 0 ? fixed : (bound - cur + G_ - 1) / G_; want = (want + 7) & ~7; n = want < 8 ? 8 : (want > 64 ? 64 : want);
                base = TT_BASE0 + (int)__hip_atomic_fetch_add(sp, (unsigned)n, __ATOMIC_RELAXED, __HIP_MEMORY_SCOPE_AGENT); }
            st[3] = (unsigned)base; st[4] = (unsigned)n; }
        __syncthreads();
        const int base = __builtin_amdgcn_readfirstlane((int)st[3]), n = __builtin_amdgcn_readfirstlane((int)st[4]);
        __syncthreads();
        if (base < 0 || base >= TT_TOTAL) break;
        const int end = (base + n) < TT_TOTAL ? (base + n) : TT_TOTAL;
        convert_range(P, ws, lds + wz * 8192, lz, base, end, wz, 8);
        if (fixed > 0) break;
    }
}
__device__ __forceinline__ void prologue(const Args& a, LAS unsigned char* lds, int gw, int NGW, int wave, int lane) {
    unsigned char* ws = a.ws;
    LAS unsigned char* img = lds + wave * 8192;
    if (gw == 0 && lane < 31) { const float* p = a.in[0];
#pragma unroll
        for (int q = 1; q < 31; ++q) p = (lane == q) ? a.in[q] : p;
        ((const float**)(ws + WS_TBL))[lane] = p; }
    { const PSArgs P{&a};
      convert_range(P, ws, img, lane, 0, TT_BASE0, gw, NGW); }
    { bf16_t* pp = (bf16_t*)(ws + WS_PP);
      for (int i = gw * 64 + lane; i < DEPTH * 4 * 65536 / 8; i += NGW * 64) { const int e = i * 8, lg = e >> 16, d0 = e & 255; const float* w = a.in[12] + e; const float* sc = a.in[13] + lg * 256 + d0;
          const f32x4 w0 = *(const f32x4*)w, w1 = *(const f32x4*)(w + 4), s0 = *(const f32x4*)sc, s1 = *(const f32x4*)(sc + 4);
          u32x4 o; o.x = cvt_pk_bf16(w0[0] * s0[0], w0[1] * s0[1]); o.y = cvt_pk_bf16(w0[2] * s0[2], w0[3] * s0[3]); o.z = cvt_pk_bf16(w1[0] * s1[0], w1[1] * s1[1]); o.w = cvt_pk_bf16(w1[2] * s1[2], w1[3] * s1[3]);
          *(u32x4*)(pp + e) = o; } }
    { bf16_t* XB = (bf16_t*)(ws + WS_XB); u64* ss0 = (u64*)(ws + WS_CTL + (size_t)CW_SS * 4);
      for (int row = gw; row < M; row += NGW) { const float* src = row < MP ? a.in[0] + (size_t)row * D : a.in[1] + (size_t)(row - MP) * D; float s = 0.f;
#pragma unroll
          for (int j = 0; j < 8; ++j) { const int c = 4 * lane + 256 * j; const f32x4 v = *(const f32x4*)(src + c);
              u32x2 w; w.x = cvt_pk_bf16(v[0], v[1]); w.y = cvt_pk_bf16(v[2], v[3]); *(u32x2*)(XB + (size_t)row * D + c) = w; s += (v[0] * v[0] + v[1] * v[1]) + (v[2] * v[2] + v[3] * v[3]); }
#pragma unroll
          for (int o = 1; o < 64; o <<= 1) s += __shfl_xor(s, o);
          if (lane == 0) ss0[row] = ss_fix(s); } }
    { float* rope = (float*)(ws + WS_ROPE);
      const float inv[8] = {1.0f, 1.939227432e-01f, 3.760603070e-02f, 7.292664610e-03f, 1.414213562e-03f, 2.742481884e-04f, 5.318296098e-05f, 1.031338616e-05f};
      for (int i = gw * 64 + lane; i < 2056 * 8; i += NGW * 64) { const int p = i >> 3, f = i & 7; const int pos = p < 2048 ? p : 16384 + (p - 2048);
          float iv = inv[0];
#pragma unroll
          for (int q = 1; q < 8; ++q) iv = (f == q) ? inv[q] : iv;
          const float ang = (float)pos * iv;
          double rev = (double)ang * 0.15915494309189535; rev -= __builtin_rint(rev);
          const float rv = (float)rev;
          rope[p * 16 + f] = __builtin_amdgcn_cosf(rv); rope[p * 16 + 8 + f] = __builtin_amdgcn_sinf(rv); } }
}

__device__ __forceinline__ void unpack8(const u32x4 w, float (&f)[16], int o) { f[o + 0] = bf_lo(w.x); f[o + 1] = bf_hi(w.x); f[o + 2] = bf_lo(w.y); f[o + 3] = bf_hi(w.y); f[o + 4] = bf_lo(w.z); f[o + 5] = bf_hi(w.z); f[o + 6] = bf_lo(w.w); f[o + 7] = bf_hi(w.w); }

constexpr int KS_STRIDE = 72, VT_STRIDE = 264, VT_OFF = 256 * KS_STRIDE * 2;
template <bool FULL>
__device__ __forceinline__ void attn_compute(const Ctx& C, LAS unsigned char* lds, const bf16_t* Z, int row0, int q0, int nq_, int nspan, int pidx0, int has_past, int kvh, int wid, int lane) {
    const int nq = FULL ? 128 : nq_;
    const int g = wid >> 1, qh = wid & 1, head = kvh * 4 + g, fr = lane & 15, fq = lane >> 4;
    constexpr float LOG2E = 1.4426950408889634f, SC = 0.125f * LOG2E;
    const int smin = has_past ? 0 : ((128 - q0) > 0 ? (128 - q0) : 0), smax = nspan - 1;
    const float sink2 = C.sinks()[head] * LOG2E;
    u32x4 qraw0 = (u32x4){0u, 0u, 0u, 0u}, qraw1 = (u32x4){0u, 0u, 0u, 0u};
    { const int qi0 = 64 * qh + fr; if (64 * qh < nq && qi0 < nq) { const bf16_t* qp = Z + (size_t)(row0 + q0 + qi0) * NIN + ZC_Q + head * 64 + 8 * fq; qraw0 = *(const u32x4*)qp; qraw1 = *(const u32x4*)(qp + 32); } }
#pragma unroll 1
    for (int qp = 0; qp < 2; ++qp) {
    if (!FULL && 64 * qh + 32 * qp >= nq) break;
#pragma unroll
    for (int q2 = 0; q2 < 2; ++q2) { const int qb = 2 * qp + q2;
        if (!FULL && 64 * qh + 16 * qb >= nq) break;
        const int qi = 64 * qh + 16 * qb + fr; const bool qv = qi < nq;
        bf16x8 qf[2];
        { float x[16];
          unpack8(qraw0, x, 0); unpack8(qraw1, x, 8);
          { qraw0 = (u32x4){0u, 0u, 0u, 0u}; qraw1 = (u32x4){0u, 0u, 0u, 0u};
            const int qn_ = qi + 16; if (qb < 3 && 64 * qh + 16 * (qb + 1) < nq && qn_ < nq) { const bf16_t* qp = Z + (size_t)(row0 + q0 + qn_) * NIN + ZC_Q + head * 64 + 8 * fq; qraw0 = *(const u32x4*)qp; qraw1 = *(const u32x4*)(qp + 32); } }
          float ss = 0.f;
#pragma unroll
          for (int j = 0; j < 16; ++j) ss += x[j] * x[j];
          ss = xsum_16_32(ss);
          const float rs = rsqrtf(ss * (1.0f / 64.0f) + RMS_EPS);
#pragma unroll
          for (int j = 0; j < 8; ++j) { x[j] = x[j] * rs * C.qn()[8 * fq + j]; x[8 + j] = x[8 + j] * rs * C.qn()[32 + 8 * fq + j]; }
          const float* rp = C.rope() + (size_t)(pidx0 + q0 + (qv ? qi : 0)) * 16;
#pragma unroll
          for (int j = 0; j < 8; ++j) { const float cs = rp[j], sn = rp[8 + j];
              u32x2v pr = __builtin_amdgcn_permlane16_swap(__float_as_uint(x[j]), __float_as_uint(x[j]), false, false); const float xe = __uint_as_float(pr[0]), xo = __uint_as_float(pr[1]);
              const float r0 = xe * cs - xo * sn, r1 = xo * cs + xe * sn; x[j] = (fq == 0) ? r0 : ((fq == 1) ? r1 : x[j]); }
          u32x4 w0, w1; w0.x = cvt_pk_bf16(x[0], x[1]); w0.y = cvt_pk_bf16(x[2], x[3]); w0.z = cvt_pk_bf16(x[4], x[5]); w0.w = cvt_pk_bf16(x[6], x[7]);
          w1.x = cvt_pk_bf16(x[8], x[9]); w1.y = cvt_pk_bf16(x[10], x[11]); w1.z = cvt_pk_bf16(x[12], x[13]); w1.w = cvt_pk_bf16(x[14], x[15]);
          qf[0] = __builtin_bit_cast(bf16x8, w0); qf[1] = __builtin_bit_cast(bf16x8, w1); }
        const int kbase = 64 * qh + 16 * qb;
        const int lo = qi > smin ? qi : smin, hi = (qi + 128) < smax ? (qi + 128) : smax;
        f32x4 S[9];
#pragma unroll
        for (int kb = 0; kb < 9; ++kb) { S[kb] = (f32x4){0.f, 0.f, 0.f, 0.f};
#pragma unroll
            for (int ks = 0; ks < 2; ++ks) { const bf16x8 kfr = *(const LAS bf16x8*)(lds + (kbase + 16 * kb + fr) * (KS_STRIDE * 2) + (32 * ks + 8 * fq) * 2);
                S[kb] = __builtin_amdgcn_mfma_f32_16x16x32_bf16(kfr, qf[ks], S[kb], 0, 0, 0); } }
        float mx = sink2;
#pragma unroll
        for (int kb = 0; kb < 9; ++kb)
#pragma unroll
            for (int i = 0; i < 4; ++i) { const int sk = kbase + 16 * kb + 4 * fq + i; float v = S[kb][i] * SC; v = (sk >= lo && sk <= hi) ? v : -1e30f; S[kb][i] = v; mx = fmaxf(mx, v); }
        mx = xmax_16_32(mx);
        float lrow = (fq == 0) ? __builtin_amdgcn_exp2f(sink2 - mx) : 0.f;
#pragma unroll
        for (int kb = 0; kb < 9; ++kb)
#pragma unroll
            for (int i = 0; i < 4; ++i) { const float pv = __builtin_amdgcn_exp2f(S[kb][i] - mx); S[kb][i] = pv; lrow += pv; }
        f32x4 O[4];
#pragma unroll
        for (int db = 0; db < 4; ++db) O[db] = (f32x4){0.f, 0.f, 0.f, 0.f};
#pragma unroll
        for (int kk = 0; kk < 5; ++kk) { u32x4 pw; pw.x = cvt_pk_bf16(S[2 * kk][0], S[2 * kk][1]); pw.y = cvt_pk_bf16(S[2 * kk][2], S[2 * kk][3]);
            if (kk < 4) { pw.z = cvt_pk_bf16(S[2 * kk + 1][0], S[2 * kk + 1][1]); pw.w = cvt_pk_bf16(S[2 * kk + 1][2], S[2 * kk + 1][3]); } else { pw.z = 0u; pw.w = 0u; }
            const bf16x8 pf = __builtin_bit_cast(bf16x8, pw);
#pragma unroll
            for (int db = 0; db < 4; ++db) { const LAS unsigned char* vb = lds + VT_OFF + (16 * db + fr) * (VT_STRIDE * 2) + (kbase + 32 * kk + 4 * fq) * 2;
                const u32x2 v0 = *(const LAS u32x2*)vb, v1 = (kk < 4) ? *(const LAS u32x2*)(vb + 32) : v0;
                u32x4 vw; vw.x = v0.x; vw.y = v0.y; vw.z = v1.x; vw.w = v1.y;
                O[db] = __builtin_amdgcn_mfma_f32_16x16x32_bf16(__builtin_bit_cast(bf16x8, vw), pf, O[db], 0, 0, 0); } }
        const float lt = xsum_16_32(lrow); const float inv = 1.0f / lt;
        if (qv) { bf16_t* op = C.BR() + (size_t)(row0 + q0 + qi) * NBR + BRC_ATT + head * 64 + 4 * fq;
#pragma unroll
            for (int db = 0; db < 4; ++db) { const f32x4 o = O[db] * inv; u32x2 w; w.x = cvt_pk_bf16(o[0], o[1]); w.y = cvt_pk_bf16(o[2], o[3]); *(u32x2*)(op + 16 * db) = w; } }
    }
    }
}
__device__ __forceinline__ void attn_unit(const Ctx& C, LAS unsigned char* lds, int a, int tid, int wid, int lane) {
    int T, row0, pidx0, has_past, b, kvh, q0;
    if (a < 256) { b = a >> 6; kvh = (a >> 4) & 3; q0 = (a & 15) * 128; T = 2048; row0 = b * 2048; pidx0 = 0; has_past = 0; }
    else { const int a2 = a - 256; b = a2 >> 2; kvh = a2 & 3; q0 = 0; T = 8; row0 = MP + 8 * b; pidx0 = 2048; has_past = 1; }
    const int nq = (T - q0) < 128 ? (T - q0) : 128, nspan = 128 + nq;
    const bool lastblk = (q0 + nq == T);
    const bf16_t* Z = C.Z();
#pragma unroll 1
    for (int pass = 0; pass < 2; ++pass) {
        const int s = pass * 128 + (tid >> 2), p = tid & 3, tk = q0 - 128 + s;
        float kf[16], vf[16];
#pragma unroll
        for (int j = 0; j < 16; ++j) { kf[j] = 0.f; vf[j] = 0.f; }
        const bool fromz = (s < nspan) && (tk >= 0), frompast = (s < nspan) && (tk < 0) && has_past;
        if (fromz) { const bf16_t* kp = Z + (size_t)(row0 + tk) * NIN + ZC_K + kvh * 64 + p * 16; const bf16_t* vp = Z + (size_t)(row0 + tk) * NIN + ZC_V + kvh * 64 + p * 16;
            unpack8(*(const u32x4*)kp, kf, 0); unpack8(*(const u32x4*)(kp + 8), kf, 8); unpack8(*(const u32x4*)vp, vf, 0); unpack8(*(const u32x4*)(vp + 8), vf, 8); }
        if (frompast) { const GAS float* kp = C.cache_k() + (((size_t)b * 128 + (128 + tk)) * 4 + kvh) * 64 + p * 16; const GAS float* vp = C.cache_v() + (((size_t)b * 128 + (128 + tk)) * 4 + kvh) * 64 + p * 16;
#pragma unroll
            for (int j = 0; j < 4; ++j) { const f32x4 kv = *(const GAS f32x4*)(kp + 4 * j), vv = *(const GAS f32x4*)(vp + 4 * j);
#pragma unroll
                for (int e = 0; e < 4; ++e) { kf[4 * j + e] = kv[e]; vf[4 * j + e] = vv[e]; } } }
        float ss = 0.f;
#pragma unroll
        for (int j = 0; j < 16; ++j) ss += kf[j] * kf[j];
        ss += __shfl_xor(ss, 1); ss += __shfl_xor(ss, 2);
        if (fromz) { const float rs = rsqrtf(ss * (1.0f / 64.0f) + RMS_EPS);
#pragma unroll
            for (int j = 0; j < 16; ++j) kf[j] = kf[j] * rs * C.kn()[p * 16 + j];
            if (p == 0) { const float* rp = C.rope() + (size_t)(pidx0 + tk) * 16;
#pragma unroll
                for (int i = 0; i < 8; ++i) { const float cs = rp[i], sn = rp[8 + i], x1 = kf[i], x2 = kf[8 + i]; kf[i] = x1 * cs - x2 * sn; kf[8 + i] = x2 * cs + x1 * sn; } } }
        { u32x4 w0, w1; w0.x = cvt_pk_bf16(kf[0], kf[1]); w0.y = cvt_pk_bf16(kf[2], kf[3]); w0.z = cvt_pk_bf16(kf[4], kf[5]); w0.w = cvt_pk_bf16(kf[6], kf[7]);
          w1.x = cvt_pk_bf16(kf[8], kf[9]); w1.y = cvt_pk_bf16(kf[10], kf[11]); w1.z = cvt_pk_bf16(kf[12], kf[13]); w1.w = cvt_pk_bf16(kf[14], kf[15]);
          *(LAS u32x4*)(lds + s * (KS_STRIDE * 2) + p * 32) = w0; *(LAS u32x4*)(lds + s * (KS_STRIDE * 2) + p * 32 + 16) = w1; }
#pragma unroll
        for (int j = 0; j < 16; ++j) *(LAS bf16_t*)(lds + VT_OFF + (p * 16 + j) * (VT_STRIDE * 2) + s * 2) = f2bf(vf[j]);
        if (lastblk && s >= nq && s < nspan) { const int w = s - nq; float* ko = C.o_k(has_past) + (((size_t)b * 128 + w) * 4 + kvh) * 64 + p * 16; float* vo = C.o_v(has_past) + (((size_t)b * 128 + w) * 4 + kvh) * 64 + p * 16;
#pragma unroll
            for (int j = 0; j < 4; ++j) { *(f32x4*)(ko + 4 * j) = (f32x4){kf[4 * j], kf[4 * j + 1], kf[4 * j + 2], kf[4 * j + 3]}; *(f32x4*)(vo + 4 * j) = (f32x4){vf[4 * j], vf[4 * j + 1], vf[4 * j + 2], vf[4 * j + 3]}; } }
    }
    __syncthreads();
    if (nq == 128) attn_compute<true>(C, lds, Z, row0, q0, nq, nspan, pidx0, has_past, kvh, wid, lane);
    else attn_compute<false>(C, lds, Z, row0, q0, nq, nspan, pidx0, has_past, kvh, wid, lane);
    __syncthreads();
}

constexpr int LRU_WREG = 14976, LRU_WOFF = 8 * LRU_WREG, LRU_W1D = (RING_BYTES + 2048) - LRU_WOFF;
static_assert(LRU_WOFF + 9216 <= RING_BYTES && RING_BYTES + 2048 + 9216 <= LDS_BYTES, "LRU LDS map");
template <bool WLDS>
__device__ __forceinline__ void lru_local(const Ctx& C, LAS unsigned char* wl, const LAS unsigned char* wlds, int b, int row0, int T, int has_past, int h, int t0, int ntok, int lane, unsigned (&ub)[64], float& Aout, float& Hout) {
    const int ch = 64 * h + lane, fr = lane & 15, fq = lane >> 4;
    LAS bf16_t* xs = (LAS bf16_t*)wl;
    LAS bf16_t* xcb = (LAS bf16_t*)(wl + 2432);
    LAS float* gr = (LAS float*)(wl + 4736);
    LAS float* gi = (LAS float*)(wl + 4736 + 4096);
    LAS bf16_t* gs = (LAS bf16_t*)(wl + 12928);
    const float cw0 = C.conv_w()[ch], cw1 = C.conv_w()[1024 + ch], cw2 = C.conv_w()[2048 + ch], cw3 = C.conv_w()[3072 + ch], cb = C.conv_b()[ch];
    constexpr float LOG2E_F = 1.4426950408889634f;
    const float nba = -LOG2E_F * C.ba()[ch], nbx = -LOG2E_F * C.bx()[ch];
    float cs; { const float xl = -C.lam()[ch]; cs = (-8.0f * LOG2E_F) * (fmaxf(xl, 0.f) + log1pf(__expf(-fabsf(xl)))); }
    const bf16_t* wap = C.WaT() + h * 4096 + fr * 64 + 8 * fq; const bf16_t* wxp = C.WxT() + h * 4096 + fr * 64 + 8 * fq;
    float hloc = 0.f, aprod = 1.f;
    u32x4 nv[3], ng[2];
#define LRU_XLOAD(TBASE) do { _Pragma("unroll") for (int j = 0; j < 2; ++j) { const int idx = lane + 64 * j, r = idx >> 3, c8 = idx & 7, tt = (TBASE) + r; \
        unsigned zz = 0u; asm volatile("" : "+v"(zz)); u32x4 v; v.x = zz; v.y = zz; v.z = zz; v.w = zz; \
        if (tt < T) v = *(const u32x4*)(C.Z() + (size_t)(row0 + tt) * NIN + ZC_GL + 64 * h + 8 * c8); \
        ng[j] = v; } \
    _Pragma("unroll") for (int j = 0; j < 3; ++j) { const int idx = lane + 64 * j, r = idx >> 3, c8 = idx & 7, tt = (TBASE) - 3 + r; \
        if (idx < 152) { unsigned zz = 0u; asm volatile("" : "+v"(zz)); u32x4 v; v.x = zz; v.y = zz; v.z = zz; v.w = zz; \
            if (tt >= 0 && tt < T) v = *(const u32x4*)(C.Z() + (size_t)(row0 + tt) * NIN + ZC_XL + 64 * h + 8 * c8); \
            else if (tt < 0 && has_past) { const GAS float* pp = C.state_conv() + ((size_t)b * 3 + (3 + tt)) * 1024 + 64 * h + 8 * c8; const f32x4 p0 = *(const GAS f32x4*)pp, p1 = *(const GAS f32x4*)(pp + 4); \
                v.x = cvt_pk_bf16(p0[0], p0[1]); v.y = cvt_pk_bf16(p0[2], p0[3]); v.z = cvt_pk_bf16(p1[0], p1[1]); v.w = cvt_pk_bf16(p1[2], p1[3]); } \
            nv[j] = v; } } } while (0)
    { unsigned zz = 0u; asm volatile("" : "+v"(zz)); nv[0].x = zz; nv[0].y = zz; nv[0].z = zz; nv[0].w = zz; nv[1] = nv[0]; nv[2] = nv[0]; ng[0] = nv[0]; ng[1] = nv[0]; }
    LRU_XLOAD(t0);
#pragma unroll
    for (int tb = 0; tb < 4; ++tb) {
        if (16 * tb < ntok) {
#pragma unroll
            for (int j = 0; j < 3; ++j) { const int idx = lane + 64 * j; if (idx < 152) *(LAS u32x4*)(xs + (idx >> 3) * 64 + 8 * (idx & 7)) = nv[j]; }
#pragma unroll
            for (int j = 0; j < 2; ++j) { const int idx = lane + 64 * j; *(LAS u32x4*)(gs + (idx >> 3) * 64 + 8 * (idx & 7)) = ng[j]; }
            __builtin_amdgcn_sched_barrier(0);
            if (16 * (tb + 1) < ntok) LRU_XLOAD(t0 + 16 * (tb + 1));
            __builtin_amdgcn_sched_barrier(0);
            LDS_WAIT();
            float xr[19], xc[16];
#pragma unroll
            for (int r = 0; r < 19; ++r) xr[r] = bf1(xs[r * 64 + lane]);
#pragma unroll
            for (int k = 0; k < 16; ++k) { xc[k] = __builtin_fmaf(cw3, xr[k + 3], __builtin_fmaf(cw2, xr[k + 2], __builtin_fmaf(cw1, xr[k + 1], __builtin_fmaf(cw0, xr[k], cb)))); xcb[k * 72 + lane] = f2bf(xc[k]); }
            LDS_WAIT();
            { bf16x8 af[2];
#pragma unroll
              for (int ks = 0; ks < 2; ++ks) af[ks] = *(const LAS bf16x8*)(xcb + fr * 72 + 32 * ks + 8 * fq);
#pragma unroll
              for (int db = 0; db < 4; ++db) { f32x4 ar = (f32x4){0.f, 0.f, 0.f, 0.f}, ai = (f32x4){0.f, 0.f, 0.f, 0.f};
#pragma unroll
                  for (int ks = 0; ks < 2; ++ks) { bf16x8 wav, wxv;
                      if (WLDS) { wav = *(const LAS bf16x8*)(wlds + ((16 * db + fr) * 72 + 32 * ks + 8 * fq) * 2); wxv = *(const LAS bf16x8*)(wlds + LRU_W1D + ((16 * db + fr) * 72 + 32 * ks + 8 * fq) * 2); }
                      else { wav = *(const bf16x8*)(wap + db * 1024 + 32 * ks); wxv = *(const bf16x8*)(wxp + db * 1024 + 32 * ks); }
                      ar = __builtin_amdgcn_mfma_f32_16x16x32_bf16(af[ks], wav, ar, 0, 0, 0); ai = __builtin_amdgcn_mfma_f32_16x16x32_bf16(af[ks], wxv, ai, 0, 0, 0); }
#pragma unroll
                  for (int i = 0; i < 4; ++i) { gr[(4 * fq + i) * 64 + 16 * db + fr] = ar[i]; gi[(4 * fq + i) * 64 + 16 * db + fr] = ai[i]; } } }
            LDS_WAIT();
            int gbase = lane;
#pragma unroll
            for (int k = 0; k < 16; ++k) {
                if ((k & 3) == 0) asm volatile("" : "+v"(gbase), "+v"(hloc), "+v"(aprod));
                const float r = __builtin_amdgcn_rcpf(1.0f + __builtin_amdgcn_exp2f(__builtin_fmaf(gr[k * 64 + gbase], -LOG2E_F, nba)));
                const float ig = __builtin_amdgcn_rcpf(1.0f + __builtin_amdgcn_exp2f(__builtin_fmaf(gi[k * 64 + gbase], -LOG2E_F, nbx)));
                const float aa = __builtin_amdgcn_exp2f(r * cs), bb = __builtin_amdgcn_sqrtf(__builtin_fmaf(-aa, aa, 1.0f)) * ig * xc[k];
                const float gl = bf1(gs[k * 64 + gbase]);
                const float eg = __builtin_amdgcn_exp2f(gl * __builtin_fmaf(gl * gl, 0.10294324f, 2.3022082f));
                float G = __builtin_fmaf(-gl, __builtin_amdgcn_rcpf(1.0f + eg), gl);
                const bool live = 16 * tb + k < ntok;
                float av = live ? aa : 1.0f, bm = live ? bb : 0.f;
                asm("" : "+v"(G)); asm("" : "+v"(av)); asm("" : "+v"(bm));
                hloc = av * hloc + bm; aprod *= av;
                float pg = aprod * G, hg = hloc * G; asm("" : "+v"(pg)); asm("" : "+v"(hg));
                unsigned pk = cvt_pk_bf16(pg, hg); ub[16 * tb + k] = live ? pk : 0u;
                }
            LDS_WAIT();
        } else {
#pragma unroll
            for (int k = 0; k < 16; ++k) ub[16 * tb + k] = 0u;
        }
    }
#undef LRU_XLOAD
    Aout = aprod; Hout = hloc;
}
__device__ __forceinline__ void lru_final(const Ctx& C, int row0, int h, int t0, int ntok, int lane, const unsigned (&ub)[64], float carry) {
    const int ch = 64 * h + lane;
    bf16_t* yo = C.BR() + (size_t)(row0 + t0) * NBR + BRC_LRU + ch;
#pragma unroll
    for (int k = 0; k < 64; ++k) { if (k < ntok) yo[(size_t)k * NBR] = f2bf(bf_hi(ub[k]) + bf_lo(ub[k]) * carry); }
}
__device__ __forceinline__ void lru_states(const Ctx& C, int has_past, int b, int row0, int T, int h, int lane, float hend) {
    const int ch = 64 * h + lane;
    C.o_h(has_past)[b * 1024 + ch] = hend;
#pragma unroll
    for (int j = 0; j < 3; ++j) C.o_conv(has_past)[((size_t)b * 3 + j) * 1024 + ch] = bf1(C.Z()[(size_t)(row0 + T - 3 + j) * NIN + ZC_XL + ch]);
}
#define RLX_AGENT __ATOMIC_RELAXED, __HIP_MEMORY_SCOPE_AGENT
__device__ __forceinline__ void lru_prompt_item(const Ctx& C, LAS unsigned char* lds, int item, int wave, int lane) {
    const int s = item >> 6, seq = (item >> 4) & 3, h = item & 15, row0 = seq * 2048, t0 = 512 * s + 64 * wave;
    unsigned ub[64]; float Ac, Hc;
    { const int t = wave * 64 + lane, mat = t >> 8, r = (t >> 2) & 63, ch4 = t & 3; const bf16_t* src = (mat ? C.WxT() : C.WaT()) + h * 4096 + r * 64 + ch4 * 16;
      const u32x4 v0 = *(const u32x4*)src, v1 = *(const u32x4*)(src + 8); LAS unsigned char* dst = lds + LRU_WOFF + mat * LRU_W1D + r * 144 + ch4 * 32;
      *(LAS u32x4*)dst = v0; *(LAS u32x4*)(dst + 16) = v1; }
    __syncthreads();
    lru_local<true>(C, lds + wave * LRU_WREG, lds + LRU_WOFF, seq, row0, 2048, 0, h, t0, 64, lane, ub, Ac, Hc);
    asm volatile("" : "+v"(Ac)); asm volatile("" : "+v"(Hc));
    __syncthreads();
    LAS float* xA = (LAS float*)lds; LAS float* xH = xA + 512;
    xA[wave * 64 + lane] = Ac; xH[wave * 64 + lane] = Hc;
    __syncthreads();
    float Apre = 1.f, Hpre = 0.f, Atot = 1.f, Htot = 0.f;
#pragma unroll
    for (int w = 0; w < 8; ++w) { float va = xA[w * 64 + lane], vh = xH[w * 64 + lane]; asm volatile("" : "+v"(va)); asm volatile("" : "+v"(vh));
        if (w < wave) { Hpre = va * Hpre + vh; Apre *= va; } Htot = va * Htot + vh; Atot *= va; }
    typedef GAS unsigned long long gu64;
    gu64* gbase = (gu64*)(C.ws + WS_LRUG); const unsigned tag = (unsigned)C.l + 1u;
    if (wave == 0) { gu64* gp = gbase + (size_t)item * 128 + 2 * lane;
        __hip_atomic_store(gp, ((unsigned long long)tag << 32) | __float_as_uint(Atot), RLX_AGENT); __hip_atomic_store(gp + 1, ((unsigned long long)tag << 32) | __float_as_uint(Htot), RLX_AGENT); }
    float hin = 0.f;
    for (int sp = 0; sp < s; ++sp) { gu64* gp = gbase + (size_t)(sp * 64 + seq * 16 + h) * 128 + 2 * lane; unsigned long long x0 = 0, x1 = 0;
        for (unsigned spins = 0; spins < (1u << 16); ++spins) { x0 = __hip_atomic_load(gp, RLX_AGENT); x1 = __hip_atomic_load(gp + 1, RLX_AGENT);
            if (__all((unsigned)(x0 >> 32) == tag && (unsigned)(x1 >> 32) == tag)) break; __builtin_amdgcn_s_sleep(2); }
        hin = __uint_as_float((unsigned)x0) * hin + __uint_as_float((unsigned)x1); }
    const float carry = Apre * hin + Hpre;
    lru_final(C, row0, h, t0, 64, lane, ub, carry);
    if (s == 3 && wave == 7) lru_states(C, 0, seq, row0, 2048, h, lane, Ac * carry + Hc);
    __syncthreads();
}
__device__ __forceinline__ void lru_sample_item(const Ctx& C, LAS unsigned char* wl, int item, int lane) {
    const int b = item >> 4, h = item & 15, row0 = MP + 8 * b;
    unsigned ub[64]; float Ac, Hc;
    lru_local<false>(C, wl, nullptr, b, row0, 8, 1, h, 0, 8, lane, ub, Ac, Hc);
    const float carry = C.state_h()[b * 1024 + 64 * h + lane];
    lru_final(C, row0, h, 0, 8, lane, ub, carry);
    lru_states(C, 1, b, row0, 8, h, lane, Ac * carry + Hc);
}

__device__ __forceinline__ void pool_group(const Ctx& C, int grp, int lane) {
    const int rowA = 4 * grp; int b, tA, has_past, posA, row0;
    if (rowA < MP) { b = rowA >> 11; tA = rowA & 2047; has_past = 0; posA = tA; row0 = b * 2048; } else { b = (rowA - MP) >> 3; tA = (rowA - MP) & 7; has_past = 1; posA = 16384 + tA; row0 = MP + 8 * b; }
#pragma unroll
    for (int step = 0; step < 2; ++step) { const int cidx = lane + 64 * step, g = cidx >> 5, w = 2 << g;
        float S[4][8], U[4][8];
#pragma unroll
        for (int r = 0; r < 4; ++r)
#pragma unroll
            for (int e = 0; e < 8; ++e) { S[r][e] = 0.f; U[r][e] = 0.f; }
#pragma unroll
        for (int d = 0; d < 19; ++d) { const int tt = tA + 3 - d; float v[8];
#pragma unroll
            for (int e = 0; e < 8; ++e) v[e] = 0.f;
            if (d < w + 3) {
                if (tt >= 0) { const u32x4 q = *(const u32x4*)(C.Z() + (size_t)(row0 + tt) * NIN + 8 * cidx); v[0] = bf_lo(q.x); v[1] = bf_hi(q.x); v[2] = bf_lo(q.y); v[3] = bf_hi(q.y); v[4] = bf_lo(q.z); v[5] = bf_hi(q.z); v[6] = bf_lo(q.w); v[7] = bf_hi(q.w); }
                else if (has_past) { const GAS float* pp = C.state_pool() + ((size_t)b * 15 + (15 + tt)) * 1024 + 8 * cidx; const f32x4 p0 = *(const GAS f32x4*)pp, p1 = *(const GAS f32x4*)(pp + 4);
                    v[0] = p0[0]; v[1] = p0[1]; v[2] = p0[2]; v[3] = p0[3]; v[4] = p1[0]; v[5] = p1[1]; v[6] = p1[2]; v[7] = p1[3]; } }
#pragma unroll
            for (int r = 0; r < 4; ++r) { if (d >= r) { const bool in = (d < r + w);
#pragma unroll
                for (int e = 0; e < 8; ++e) { S[r][e] += in ? v[e] : 0.f; if (d == r) U[r][e] = v[e]; } } } }
#pragma unroll
        for (int r = 0; r < 4; ++r) { const int pos = posA + 3 - r; const int cnt = (pos + 1) < w ? (pos + 1) : w; const float ic = 1.0f / (float)cnt; float dd[8];
#pragma unroll
            for (int e = 0; e < 8; ++e) dd[e] = S[r][e] * ic - U[r][e];
            u32x4 o; o.x = cvt_pk_bf16(dd[0], dd[1]); o.y = cvt_pk_bf16(dd[2], dd[3]); o.z = cvt_pk_bf16(dd[4], dd[5]); o.w = cvt_pk_bf16(dd[6], dd[7]);
            *(u32x4*)(C.BR() + (size_t)(rowA + 3 - r) * NBR + BRC_POOL + 8 * cidx) = o; } }
}
__device__ __forceinline__ void newpool_item(const Ctx& C, int item, int lane) {
    const int seq = item / 15, j = item - seq * 15; int b, T, row0, has_past;
    if (seq < 4) { b = seq; T = 2048; row0 = seq * 2048; has_past = 0; } else { b = seq - 4; T = 8; row0 = MP + 8 * b; has_past = 1; }
    const int fi = T + j; float* o = C.o_pool(has_past) + ((size_t)b * 15 + j) * 1024;
#pragma unroll
    for (int k = 0; k < 4; ++k) { const int c = 4 * lane + 256 * k; f32x4 v = (f32x4){0.f, 0.f, 0.f, 0.f};
        if (fi >= 15) { const u32x2 q = *(const u32x2*)(C.Z() + (size_t)(row0 + fi - 15) * NIN + c); v[0] = bf_lo(q.x); v[1] = bf_hi(q.x); v[2] = bf_lo(q.y); v[3] = bf_hi(q.y); }
        else if (has_past) v = *(const GAS f32x4*)(C.state_pool() + ((size_t)b * 15 + fi) * 1024 + c);
        *(f32x4*)(o + c) = v; }
}

__global__ void __launch_bounds__(512, 2) fwd(Args args) {
    extern __shared__ __attribute__((aligned(16))) unsigned char lds_raw[];
    LAS unsigned char* lds = (LAS unsigned char*)lds_raw;
    const int tid = threadIdx.x, lane = tid & 63, wave = __builtin_amdgcn_readfirstlane(tid >> 6);
    const int G = gridDim.x, bx = blockIdx.x, vcu = (G % 8 == 0) ? (bx % 8) * (G / 8) + bx / 8 : bx;
    const int gw = vcu * 8 + wave, NGW = G * 8;
    unsigned char* ws = args.ws;
    unsigned* ctl = (unsigned*)(ws + WS_CTL);
    for (int u = tid; u < (LDS_BYTES - LDSCTL_OFF) / 4; u += 512) ((LAS unsigned*)(lds + LDSCTL_OFF))[u] = 0u;
    __syncthreads();
    XcdBarrier bar; bar.bar = ctl + CW_BAR; bar.x = 0; bar.st = nullptr;
    if (!MK_PER_PHASE) bar = xcd_barrier_post(ctl + CW_BAR, (volatile LAS unsigned*)(lds + MISC_OFF) + 8);
    const int lo = args.ph_lo, hi = args.ph_hi;
    int pid = 0;
#define IN(k) (lo <= (k) && (k) < hi)
#ifndef SEAM_REPS
#define SEAM_REPS 1
#endif
#ifndef DNX
#define DNX 8
#endif
#ifndef SLOT_GU
#define SLOT_GU 40
#endif
#ifndef SLOT_IN
#define SLOT_IN 40
#endif
    unsigned* sptr = ctl + CW_SPTR; volatile LAS unsigned* bar_st = (volatile LAS unsigned*)(lds + MISC_OFF) + 8;
#define SEAM(PSV, NEED) do { if (IN(pid)) { int stid = threadIdx.x; asm volatile("" : "+v"(stid)); const int swv = __builtin_amdgcn_readfirstlane(stid >> 6); \
            (void)swv; if ((NEED) > 0) convert_wg(PSV, ws, lds, bar_st, sptr, (NEED), 0); \
            if (!MK_PER_PHASE && IN(pid + 1)) { xcd_barrier(bar); } } ++pid; } while (0)
    const PSTbl PT{(const float* const*)(ws + WS_TBL)}; const PSArgs PA{&args};
    float* X = args.out;
    bf16_t* XB = (bf16_t*)(ws + WS_XB); bf16_t* ACT = (bf16_t*)(ws + WS_ACT); bf16_t* Zb = (bf16_t*)(ws + WS_Z); bf16_t* BR = (bf16_t*)(ws + WS_BR);
    bf16_t* MB = (bf16_t*)(ws + WS_MB);
    u64* SS = (u64*)(ws + WS_CTL + (size_t)CW_SS * 4);

    if (EN(0) && IN(pid)) { for (int rep = 0; rep < REPS(0); ++rep) prologue(args, lds, gw, NGW, wave, lane); }
    SEAM(PA, tt_need(0, 0));
#pragma unroll 1
    for (int s = 0; s < 8; ++s) {
        const int l = s >> 1, which = s & 1;
        unsigned char* lw = ws + WS_W + (size_t)l * LW_STRIDE;
        if (EN(2) && IN(pid)) {
            pg8::Gemm g{XB, (const bf16_t*)(lw + (which ? LW_GUB : LW_GUA)), D, D, D};
            pg8::OrderStd S; S.init(M / 256, NGU / 256, 1, G, bx, D, D, 0, 0);
            pg8::EpiGU E{ACT, SS + (size_t)(3 * l + 2 * which) * M};
            for (int rep = 0; rep < REPS(2); ++rep) pg8::gemm_phase<false>(lds, g, S, E);
            if (s == 0) {
                const int nwg_ = (M / 256) * (NGU / 256), nmax_ = (nwg_ + G - 1) / G, nfull_ = nwg_ - (nmax_ - 1) * G, nidle_ = G - nfull_;
                if (nidle_ == 0 || bx >= nfull_) {
                    pg8::Gemm gw_{(const bf16_t*)(ws + WS_WBPT), (const bf16_t*)(ws + WS_PP), 1024, 256, 256};
                    pg8::OrderWeff Sw{nidle_ == 0 ? G : nidle_, nidle_ == 0 ? bx : bx - nfull_}; pg8::EpiWeff Ew{(bf16_t*)(ws + WS_W + LW_CAT)};
                    pg8::gemm_phase<false>(lds, gw_, Sw, Ew); }
            }
            {
                const int nwg_ = (M / 256) * (NGU / 256), nmax_ = (nwg_ + G - 1) / G, nfull_ = nwg_ - (nmax_ - 1) * G, nidle_ = G - nfull_;
                if (nidle_ == 0 || bx >= nfull_) { int ptid = threadIdx.x; asm volatile("" : "+v"(ptid)); const int plane = ptid & 63, pwave = __builtin_amdgcn_readfirstlane(ptid >> 6);
                    const PSTbl P{(const float* const*)(ws + WS_TBL)};
                    convert_wg(P, ws, lds, bar_st, sptr, TT_TOTAL, s == 0 ? SLOT_GU - 16 : SLOT_GU);     (void)plane; (void)pwave; }
            }
        }
        SEAM(PT, tt_need(l, which ? 7 : 1));
        if (EN(3) && IN(pid)) {
            pg8::Gemm g{ACT, (const bf16_t*)(lw + (which ? LW_DNB : LW_DNA)), FF, FF, FF};
            pg8::OrderRide S; S.init(G, bx, FF, FF);
            pg8::EpiRes E{(s == 7) ? X : nullptr, XB, SS + (size_t)(3 * l + 2 * which + 1) * M, 0.5f};
            pg8::gemm_phase<true>(lds, g, S, E);
            { pg8::Unit u0; if (DNX > 0 && S.next(0, u0) && u0.xrow < 0) convert_wg(PT, ws, lds, bar_st, sptr, TT_TOTAL, DNX); }
            if (REPS(3) > 1) { __syncthreads(); pg8::EpiRes E2{nullptr, XB, (u64*)(ws + WS_MRG), 0.0f}; pg8::gemm_phase<true>(lds, g, S, E2); }
        }
        SEAM(PT, (which == 0) ? tt_need(l, 2) : (l + 1 < DEPTH ? tt_need(l + 1, 0) : 0));
        if (which == 0) {
            if (EN(4) && IN(pid)) {
                pg8::Gemm g{XB, (const bf16_t*)(lw + LW_IN), D, D, D};
                pg8::OrderStd S; S.init(M / 256, NIN / 256, 1, G, bx, D, D, 0, 0);
                pg8::EpiIn E{Zb, SS + (size_t)(3 * l + 1) * M};
                for (int rep = 0; rep < REPS(4); ++rep) pg8::gemm_phase<false>(lds, g, S, E);
            {
                    const int nwg_ = (M / 256) * (NIN / 256), nmax_ = (nwg_ + G - 1) / G, nfull_ = nwg_ - (nmax_ - 1) * G, nidle_ = G - nfull_;
                    if (nidle_ == 0 || bx >= nfull_) { int ptid = threadIdx.x; asm volatile("" : "+v"(ptid)); const int plane = ptid & 63, pwave = __builtin_amdgcn_readfirstlane(ptid >> 6);
                        const PSTbl P{(const float* const*)(ws + WS_TBL)};
                        convert_wg(P, ws, lds, bar_st, sptr, TT_TOTAL, SLOT_IN); (void)plane; (void)pwave; }
                }
            }
            SEAM(PT, tt_need(l, 3));
            Ctx C; C.tbl = (const float* const*)(ws + WS_TBL); C.ws = ws; C.out = X; C.l = l;
            if (IN(pid)) {
                _Pragma("unroll 1") for (int rep = 0; rep < REPS(5); ++rep) {
                int ptid = threadIdx.x; asm volatile("" : "+v"(ptid)); const int plane = ptid & 63, pwave = __builtin_amdgcn_readfirstlane(ptid >> 6), pgw = vcu * 8 + pwave;
                _Pragma("unroll 1") for (int r2 = 0; r2 < REPS(11); ++r2) { if (EN(6)) for (int it = bx; it < 256; it += G) lru_prompt_item(C, lds, it, pwave, plane); }
                _Pragma("unroll 1") for (int r2 = 0; r2 < REPS(12); ++r2) { if (EN(5)) for (int a = bx; a < N_ATT_UNITS; a += G) attn_unit(C, lds, a, ptid, pwave, plane); }
                __syncthreads();
                if (EN(6)) for (int it = NGW - 1 - (bx * 8 + pwave); it < 512; it += NGW) lru_sample_item(C, lds + pwave * 16384, it, plane);
                { const int wlo = bx * 8 + pwave, half = (G / 2) * 8, nhi = NGW - half, NG4 = M / 4; const int share_hi = nhi > 0 ? (NG4 * 5) / 6 : 0;
                  if (EN(7)) { if (wlo >= half) { for (int g4 = wlo - half; g4 < share_hi; g4 += nhi) pool_group(C, g4, plane); for (int it = wlo - half; it < NSEQ * 15; it += nhi) newpool_item(C, it, plane); }
                               else { for (int g4 = share_hi + wlo; g4 < NG4; g4 += half) pool_group(C, g4, plane); }
                               if (nhi <= 0) for (int it = wlo; it < NSEQ * 15; it += NGW) newpool_item(C, it, plane); } }
                __syncthreads(); }
            }
            SEAM(PT, tt_need(l, 4));
            if (EN(9) && IN(pid)) {
                pg8::Gemm g{BR, (const bf16_t*)(lw + LW_CAT), NBR, NBR, NBR};
                pg8::OrderRide S; S.init(G, bx, NBR, NBR);
                pg8::EpiBr E{Zb, MB};
                for (int rep = 0; rep < REPS(9); ++rep) pg8::gemm_phase<true>(lds, g, S, E);
            }
            SEAM(PT, tt_need(l, 5));
            if (EN(10) && IN(pid)) {
                pg8::Gemm g{MB, (const bf16_t*)(lw + LW_OUT), D, D, D};
                pg8::OrderRide S; S.init(G, bx, D, D);
                pg8::EpiRes E{nullptr, XB, SS + (size_t)(3 * l + 2) * M, 1.0f};
                pg8::gemm_phase<true>(lds, g, S, E);
                if (REPS(10) > 1) { __syncthreads(); pg8::EpiRes E2{nullptr, XB, (u64*)(ws + WS_MRG), 0.0f}; pg8::gemm_phase<true>(lds, g, S, E2); }
            }
            SEAM(PT, tt_need(l, 6));
        }
    }
#undef IN
#undef SEAM
}
constexpr int N_PHASES = 1 + 4 * 8;

extern "C" void kernel_launch(void* const* d_in, const int* in_sizes, int n_in, void* d_out, int out_size, void* d_ws, size_t ws_size, hipStream_t stream) {
    static int grid = 0;
    if (grid == 0) {
        if (n_in != 31 || (size_t)out_size != O_END || ws_size < WS_END) { fprintf(stderr, "kernel_launch: unexpected shapes: n_in %d out %d (want %zu) ws %zu (want >= %zu)\n", n_in, out_size, (size_t)O_END, ws_size, (size_t)WS_END); grid = -1; return; }
        int dev = 0, cus = 0, per_cu = 0;
        if (hipGetDevice(&dev) != hipSuccess || hipDeviceGetAttribute(&cus, hipDeviceAttributeMultiprocessorCount, dev) != hipSuccess) { grid = -1; return; }
        if (hipFuncSetAttribute((const void*)fwd, hipFuncAttributeMaxDynamicSharedMemorySize, LDS_BYTES) != hipSuccess) { fprintf(stderr, "kernel_launch: hipFuncSetAttribute failed\n"); grid = -1; return; }
        if (hipOccupancyMaxActiveBlocksPerMultiprocessor(&per_cu, (const void*)fwd, 512, LDS_BYTES) != hipSuccess || per_cu < 1) fprintf(stderr, "kernel_launch: occupancy query says %d\n", per_cu);
        (void)hipGetLastError();
        grid = cus;
    }
    if (grid < 0) return;
    if (hipMemsetAsync((char*)d_ws + WS_CTL, 0, CTL_BYTES, stream) != hipSuccess) return;
    Args a{};
    for (int i = 0; i < 31; ++i) a.in[i] = (const float*)d_in[i];
    a.out = (float*)d_out; a.ws = (unsigned char*)d_ws;
#if MK_PER_PHASE
    for (int p = 0; p < N_PHASES; ++p) { a.ph_lo = p; a.ph_hi = p + 1; hipLaunchKernelGGL(fwd, dim3(grid), dim3(512), LDS_BYTES, stream, a); }
#else
    a.ph_lo = 0; a.ph_hi = N_PHASES;
    hipLaunchKernelGGL(fwd, dim3(grid), dim3(512), LDS_BYTES, stream, a);
#endif
}
```

```cpp
#include <hip/hip_runtime.h>
#include <cstdio>
#include <cstdint>

#ifndef MK_PER_PHASE
#define MK_PER_PHASE 0
#endif
#ifndef EN_MASK
#define EN_MASK 0xFFFF
#endif
#define EN(b) ((EN_MASK >> (b)) & 1)
#ifndef REP_MASK
#define REP_MASK 0
#endif
#define REPS(b) (1 + ((REP_MASK >> (b)) & 1))

#define LAS __attribute__((address_space(3)))
#define GAS __attribute__((address_space(1)))
typedef unsigned short bf16_t;
typedef short bf16x8 __attribute__((ext_vector_type(8)));
typedef float f32x4 __attribute__((ext_vector_type(4)));
typedef float f32x2 __attribute__((ext_vector_type(2)));
typedef unsigned u32x4 __attribute__((ext_vector_type(4)));
typedef unsigned u32x2 __attribute__((ext_vector_type(2)));

constexpr int D = 2048, MP = 8192, MS = 256, M = MP + MS, DEPTH = 4;
constexpr int FF = 5632, NGU = 2 * FF, NIN = 10752, NBR = 3072;
constexpr int ZC_Q = 1024, ZC_K = 2048, ZC_V = 2304, ZC_XL = 2560, ZC_GL = 3584, ZC_G = 4608;
constexpr int BRC_POOL = 0, BRC_ATT = 1024, BRC_LRU = 2048;
constexpr float RMS_EPS = 1e-6f;
constexpr int NSEQ = 36, NCHUNK = 32;
constexpr int N_ATT_UNITS = 256 + 128;
constexpr int N_LRU_ITEMS = 2048 + 512;

constexpr size_t O_Y = 0;
constexpr size_t O_POOL_P = (size_t)M * D;
constexpr size_t O_POOL_S = O_POOL_P + (size_t)4 * 4 * 15 * 1024;
constexpr size_t O_K_P = O_POOL_S + (size_t)4 * 32 * 15 * 1024;
constexpr size_t O_K_S = O_K_P + (size_t)4 * 4 * 128 * 256;
constexpr size_t O_V_P = O_K_S + (size_t)4 * 32 * 128 * 256;
constexpr size_t O_V_S = O_V_P + (size_t)4 * 4 * 128 * 256;
constexpr size_t O_CONV_P = O_V_S + (size_t)4 * 32 * 128 * 256;
constexpr size_t O_CONV_S = O_CONV_P + (size_t)4 * 4 * 3 * 1024;
constexpr size_t O_H_P = O_CONV_S + (size_t)4 * 32 * 3 * 1024;
constexpr size_t O_H_S = O_H_P + (size_t)4 * 4 * 1024;
constexpr size_t O_END = O_H_S + (size_t)4 * 32 * 1024;

constexpr size_t MiB = 1u << 20;
constexpr size_t WS_CTL = 0, CTL_BYTES = 2 * MiB;
constexpr int CW_TMO = 0, CW_BAR = 4096, CW_SS = 16384;
constexpr size_t WS_LRUG = 1 * MiB;
constexpr size_t WS_ROPE = 2 * MiB;
constexpr size_t WS_TBL = 2 * MiB + 512 * 1024;
constexpr size_t WS_SUMM = 3 * MiB;
constexpr size_t WS_PP = 4 * MiB;
constexpr size_t WS_GATE = 6 * MiB;
constexpr size_t WS_WBPT = 8 * MiB;
constexpr size_t WS_W = 24 * MiB;
constexpr size_t LW_GUA = 0, LW_DNA = 44 * MiB, LW_IN = 66 * MiB, LW_CAT = 108 * MiB, LW_OUT = 120 * MiB, LW_GUB = 128 * MiB, LW_DNB = 172 * MiB, LW_STRIDE = 194 * MiB;
constexpr size_t WS_XB = WS_W + 4 * LW_STRIDE;
constexpr size_t WS_ACT = WS_XB + 33 * MiB;
constexpr size_t WS_Z = WS_ACT + 91 * MiB;
constexpr size_t WS_BR = WS_Z + 174 * MiB;
constexpr size_t WS_MRG = WS_BR + 50 * MiB;
constexpr size_t WS_MB = WS_MRG + 66 * MiB;
constexpr size_t WS_END = WS_MB + 33 * MiB;
static_assert((size_t)CW_SS * 4 + (size_t)13 * M * 8 <= CTL_BYTES, "ctl");
static_assert((size_t)M * D * 2 <= 33 * MiB && (size_t)M * FF * 2 <= 91 * MiB && (size_t)M * NIN * 2 <= 174 * MiB && (size_t)M * NBR * 2 <= 50 * MiB && (size_t)M * D * 4 <= 66 * MiB, "ws");
static_assert((size_t)NGU * D * 2 <= 44 * MiB && (size_t)D * FF * 2 <= 22 * MiB && (size_t)NIN * D * 2 <= 42 * MiB && (size_t)D * NBR * 2 <= 12 * MiB && (size_t)D * D * 2 <= 8 * MiB, "ws w");

constexpr int RING_BYTES = 131072;
constexpr int LDSCTL_OFF = RING_BYTES, MISC_OFF = LDSCTL_OFF + 320;
constexpr int LDS_BYTES = 147456;

typedef __bf16 bf16x2_t __attribute__((ext_vector_type(2)));
__device__ __forceinline__ unsigned cvt_pk_bf16(float lo, float hi) { const f32x2 v = {lo, hi}; return __builtin_bit_cast(unsigned, __builtin_convertvector(v, bf16x2_t)); }
__device__ __forceinline__ float bf_lo(unsigned w) { return __uint_as_float(w << 16); }
__device__ __forceinline__ float bf_hi(unsigned w) { return __uint_as_float(w & 0xffff0000u); }
__device__ __forceinline__ float bf1(bf16_t b) { return __uint_as_float(((unsigned)b) << 16); }
__device__ __forceinline__ bf16_t f2bf(float f) { return (bf16_t)(cvt_pk_bf16(f, 0.f) & 0xffffu); }
__device__ __forceinline__ float sigmoidf_(float x) { return __builtin_amdgcn_rcpf(1.0f + __expf(-x)); }
typedef unsigned u32x2v __attribute__((ext_vector_type(2)));
__device__ __forceinline__ float xsum_16_32(float x) {
    u32x2v r = __builtin_amdgcn_permlane16_swap(__float_as_uint(x), __float_as_uint(x), false, false); const float y = __uint_as_float(r[0]) + __uint_as_float(r[1]);
    u32x2v q = __builtin_amdgcn_permlane32_swap(__float_as_uint(y), __float_as_uint(y), false, false); return __uint_as_float(q[0]) + __uint_as_float(q[1]); }
__device__ __forceinline__ float xmax_16_32(float x) {
    u32x2v r = __builtin_amdgcn_permlane16_swap(__float_as_uint(x), __float_as_uint(x), false, false); const float y = fmaxf(__uint_as_float(r[0]), __uint_as_float(r[1]));
    u32x2v q = __builtin_amdgcn_permlane32_swap(__float_as_uint(y), __float_as_uint(y), false, false); return fmaxf(__uint_as_float(q[0]), __uint_as_float(q[1])); }
__device__ __forceinline__ float expm1_neg(float x) { const float p = x * (1.0f + x * (0.5f + x * (0.16666667f + x * (0.041666668f + x * (0.0083333338f + x * 0.0013888889f))))); return x > -0.35f ? p : __expf(x) - 1.0f; }
typedef unsigned long long u64;
__device__ __forceinline__ u64 ss_fix(float s) { return (u64)((double)s * 68719476736.0 + 0.5); }
__device__ __forceinline__ float rstd_of(unsigned hi) { return rsqrtf((float)hi * (1.0f / 16.0f / 2048.0f) + RMS_EPS); }
#define LDS_WAIT() asm volatile("s_waitcnt lgkmcnt(0)" ::: "memory")
#define VM_WAIT() asm volatile("s_waitcnt vmcnt(0)" ::: "memory")

namespace pg8 {
constexpr int BM = 256, BK = 64, HALF = 128, HTB = HALF * BK * 2, STAGE_BYTES = 8 * HTB, NXCD = 8, WGM = 8;
__device__ __forceinline__ int lds_byte(int r, int c) { const int st = (r >> 4) * 2 + (c >> 5), rr = r & 15, cc = c & 31, ob = rr * 64 + cc * 2; return st * 1024 + (ob ^ (((ob >> 9) & 1) << 5)); }
__device__ __forceinline__ void stage_rc(int b, int& R, int& C) { const int st = b / 1024, sb = b % 1024, swz = sb ^ (((sb >> 9) & 1) << 5); R = (st >> 1) * 16 + swz / 64; C = (st & 1) * 32 + (swz % 64) / 2; }
__device__ __forceinline__ int perm32(int rho) { const int n = rho >> 4, i = rho & 15; return 8 * (i >> 2) + 4 * n + (i & 3); }

struct Unit { int pm, pn, pz, xrow; long aoff, boff, xoff; };
struct Gemm { const bf16_t* A; const bf16_t* Bt; int lda, ldb, K; };

struct OrderStd {
    int nM, nN, nZ, nwg, G, c; long aM, aZ, bN, bZ;
    __device__ __forceinline__ void init(int nM_, int nN_, int nZ_, int G_, int c_, long lda, long ldb, long aZ_, long bZ_) {
        nM = nM_; nN = nN_; nZ = nZ_; nwg = nM * nN; G = G_; c = c_; aM = 256 * lda; bN = 256 * ldb; aZ = aZ_; bZ = bZ_; }
    __device__ __forceinline__ bool next(int i, Unit& u) const {
        const int j = i / nZ, z = i - j * nZ;
        const long L = (long)j * G + c; if (L >= nwg) return false;
        int wgid = (int)L; { const int q = nwg / NXCD, r = nwg % NXCD, xcd = wgid % NXCD, off = wgid / NXCD; wgid = (xcd < r ? xcd * (q + 1) : r * (q + 1) + (xcd - r) * q) + off; }
        const int nig = WGM * nN, gid = wgid / nig, fm = gid * WGM, gsz = (nM - fm) < WGM ? (nM - fm) : WGM;
        u.pm = fm + ((wgid % nig) % gsz); u.pn = (wgid % nig) / gsz; u.pz = z;
        u.aoff = (long)u.pm * aM + (long)z * aZ; u.boff = (long)u.pn * bN + (long)z * bZ; u.xrow = -1; u.xoff = u.aoff; return true;
    }
};
struct OrderRide {
    OrderStd o; long lda;
    __device__ __forceinline__ void init(int G_, int c_, long lda_, long ldb) { o.init(MP / 256, D / 256, 1, G_, c_, lda_, ldb, 0, 0); lda = lda_; }
    __device__ __forceinline__ bool next(int i, Unit& u) const { if (!o.next(i, u)) return false; if (u.pm < 16) { u.xrow = MP + 16 * u.pm; u.xoff = (long)u.xrow * lda; } return true; }
};
struct OrderWeff {
    int G, c;
    __device__ __forceinline__ bool next(int i, Unit& u) const {
        const int L = i * G + c; if (L >= 128) return false;
        const int layer = L >> 5, g = (L >> 3) & 3, pm = L & 7;
        u.pm = pm; u.pn = 0; u.pz = layer * 4 + g;
        u.aoff = (long)layer * 2048 * 1024 + (long)g * 256 + (long)pm * 256 * 1024; u.boff = (long)(layer * 4 + g) * 65536; u.xrow = -1; u.xoff = u.aoff; return true;
    }
};

struct EpiGU {
    static constexpr bool PERM = true, HOOK = false, PRE = true;
    bf16_t* act; const u64* ss;
    __device__ __forceinline__ void pre(const Unit& u, int wr, int fr, unsigned (&rq)[8]) const {
#pragma unroll
        for (int i = 0; i < 8; ++i) rq[i] = ((const unsigned*)ss)[2 * (u.pm * BM + wr * 64 + fr + (i >> 2) * HALF + (i & 3) * 16) + 1]; }
    __device__ __forceinline__ void operator()(const f32x4 (&acc)[2][2][4][2], const Unit& u, int wr, int wc, int fr, int fq, const unsigned (&rq)[8]) const {
        const int row0 = u.pm * BM + wr * 64 + fr, col = u.pn * 128 + wc * 32 + 8 * fq;
#pragma unroll
        for (int ai = 0; ai < 2; ++ai)
#pragma unroll
            for (int m = 0; m < 4; ++m) { const int row = row0 + ai * HALF + m * 16; const float rs = rstd_of(rq[ai * 4 + m]);
                float o[8];
#pragma unroll
                for (int n = 0; n < 2; ++n)
#pragma unroll
                    for (int j = 0; j < 4; ++j) { const float g = acc[ai][0][m][n][j] * rs, uu = acc[ai][1][m][n][j] * rs; o[n * 4 + j] = g * sigmoidf_(g) * uu; }
                u32x4 w; w.x = cvt_pk_bf16(o[0], o[1]); w.y = cvt_pk_bf16(o[2], o[3]); w.z = cvt_pk_bf16(o[4], o[5]); w.w = cvt_pk_bf16(o[6], o[7]);
                *(u32x4*)(act + (size_t)row * FF + col) = w; }
    }
};
struct EpiIn {
    static constexpr bool PERM = true, HOOK = false, PRE = true;
    bf16_t* Z; const u64* ss;
    __device__ __forceinline__ void pre(const Unit& u, int wr, int fr, unsigned (&rq)[8]) const {
#pragma unroll
        for (int i = 0; i < 8; ++i) rq[i] = ((const unsigned*)ss)[2 * (u.pm * BM + wr * 64 + fr + (i >> 2) * HALF + (i & 3) * 16) + 1]; }
    __device__ __forceinline__ void operator()(const f32x4 (&acc)[2][2][4][2], const Unit& u, int wr, int wc, int fr, int fq, const unsigned (&rq)[8]) const {
        const int row0 = u.pm * BM + wr * 64 + fr, col = u.pn * BM + wc * 32 + 8 * fq; const bool sig = u.pn >= 18;
#pragma unroll
        for (int ai = 0; ai < 2; ++ai)
#pragma unroll
            for (int m = 0; m < 4; ++m) { const int row = row0 + ai * HALF + m * 16; const float rs = rstd_of(rq[ai * 4 + m]);
#pragma unroll
                for (int bj = 0; bj < 2; ++bj) { float o[8];
#pragma unroll
                    for (int n = 0; n < 2; ++n)
#pragma unroll
                        for (int j = 0; j < 4; ++j) { float v = acc[ai][bj][m][n][j] * rs; if (sig) v = sigmoidf_(v); o[n * 4 + j] = v; }
                    u32x4 w; w.x = cvt_pk_bf16(o[0], o[1]); w.y = cvt_pk_bf16(o[2], o[3]); w.z = cvt_pk_bf16(o[4], o[5]); w.w = cvt_pk_bf16(o[6], o[7]);
                    *(u32x4*)(Z + (size_t)row * NIN + col + bj * HALF) = w; } }
    }
};
struct EpiRes {
    static constexpr bool PERM = true, HOOK = false, PRE = false;
    __device__ __forceinline__ void pre(const Unit&, int, int, unsigned (&)[8]) const {}
    float* Y; bf16_t* XB; u64* ssn; float scale;
    __device__ __forceinline__ float one8(const f32x4 a0, const f32x4 a1, unsigned off) const {
        const u32x4 xw = *(const u32x4*)(XB + off); f32x4 x0, x1;
        x0[0] = bf_lo(xw.x); x0[1] = bf_hi(xw.x); x0[2] = bf_lo(xw.y); x0[3] = bf_hi(xw.y); x1[0] = bf_lo(xw.z); x1[1] = bf_hi(xw.z); x1[2] = bf_lo(xw.w); x1[3] = bf_hi(xw.w);
        x0 = x0 + a0 * scale; x1 = x1 + a1 * scale; if (Y) { *(f32x4*)(Y + off) = x0; *(f32x4*)(Y + off + 4) = x1; }
        u32x4 w; w.x = cvt_pk_bf16(x0[0], x0[1]); w.y = cvt_pk_bf16(x0[2], x0[3]); w.z = cvt_pk_bf16(x1[0], x1[1]); w.w = cvt_pk_bf16(x1[2], x1[3]); *(u32x4*)(XB + off) = w;
        const float r0 = bf_lo(w.x), r1 = bf_hi(w.x), r2 = bf_lo(w.y), r3 = bf_hi(w.y), r4 = bf_lo(w.z), r5 = bf_hi(w.z), r6 = bf_lo(w.w), r7 = bf_hi(w.w);
        return ((r0 * r0 + r1 * r1) + (r2 * r2 + r3 * r3)) + ((r4 * r4 + r5 * r5) + (r6 * r6 + r7 * r7)); }
    __device__ __forceinline__ void operator()(const f32x4 (&acc)[2][2][4][2], const Unit& u, int wr, int wc, int fr, int fq, const unsigned (&)[8]) const {
        const int row0 = u.pm * BM + wr * 64 + fr, col0 = u.pn * BM + wc * 32 + 8 * fq;
#pragma unroll
        for (int ai = 0; ai < 2; ++ai)
#pragma unroll
            for (int mp = 0; mp < 2; ++mp) { const int rowa = row0 + ai * HALF + (2 * mp) * 16, rowb = rowa + 16; float sa = 0.f, sb = 0.f;
#pragma unroll
                for (int bj = 0; bj < 2; ++bj) sa += one8(acc[ai][bj][2 * mp][0], acc[ai][bj][2 * mp][1], (unsigned)rowa * (unsigned)D + (unsigned)(col0 + bj * HALF));
#pragma unroll
                for (int bj = 0; bj < 2; ++bj) sb += one8(acc[ai][bj][2 * mp + 1][0], acc[ai][bj][2 * mp + 1][1], (unsigned)rowb * (unsigned)D + (unsigned)(col0 + bj * HALF));
                u32x2v p = __builtin_amdgcn_permlane16_swap(__float_as_uint(sa), __float_as_uint(sb), false, false);
                const float t = __uint_as_float(p[0]) + __uint_as_float(p[1]);
                u32x2v q = __builtin_amdgcn_permlane32_swap(__float_as_uint(t), __float_as_uint(t), false, false);
                const float tot = __uint_as_float(q[0]) + __uint_as_float(q[1]);
                if (fq < 2) atomicAdd(ssn + (fq == 0 ? rowa : rowb), ss_fix(tot));
                asm volatile("" ::: "memory"); }
    }
    __device__ __forceinline__ void extra(const f32x4 (&accx)[2], const Unit& u, int wr, int wc, int fr, int fq) const {
        const int row = u.xrow + fr; float s = one8(accx[0], accx[1], (unsigned)row * (unsigned)D + (unsigned)(u.pn * BM + wr * HALF + wc * 32 + 8 * fq));
        s += __shfl_xor(s, 16); s += __shfl_xor(s, 32);
        if (fq == 0) atomicAdd(ssn + row, ss_fix(s));
    }
};
struct EpiBr {
    static constexpr bool PERM = true, HOOK = true, PRE = false;
    __device__ __forceinline__ void pre(const Unit&, int, int, unsigned (&)[8]) const {}
    const bf16_t* Z; bf16_t* MB;
    __device__ __forceinline__ void gate8(int row, int col, int z, f32x4& g0, f32x4& g1) const {
        const unsigned idx = (unsigned)row * (unsigned)NIN + (unsigned)(ZC_G + D * z + col); const u32x4 gw = *(const u32x4*)(Z + idx);
        g0[0] = bf_lo(gw.x); g0[1] = bf_hi(gw.x); g0[2] = bf_lo(gw.y); g0[3] = bf_hi(gw.y); g1[0] = bf_lo(gw.z); g1[1] = bf_hi(gw.z); g1[2] = bf_lo(gw.w); g1[3] = bf_hi(gw.w); }
    __device__ __forceinline__ void ratio8(int row, int col, int z, f32x4& r0, f32x4& r1) const {
        f32x4 a0, a1, b0, b1; gate8(row, col, z, a0, a1); gate8(row, col, z + 1, b0, b1);
#pragma unroll
        for (int j = 0; j < 4; ++j) { r0[j] = a0[j] * __builtin_amdgcn_rcpf(fmaxf(b0[j], 5.9604645e-08f)); r1[j] = a1[j] * __builtin_amdgcn_rcpf(fmaxf(b1[j], 5.9604645e-08f)); } }
    __device__ __forceinline__ bool hook_at(int t) const { return t == 16 || t == 32; }
    __device__ __forceinline__ void mid(f32x4 (&acc)[2][2][4][2], f32x4 (&accx)[2], const Unit& u, int t, int wr, int wc, int fr, int fq) const {
        const int z = (t >> 4) - 1, row0 = u.pm * BM + wr * 64 + fr, col0 = u.pn * BM + wc * 32 + 8 * fq;
#pragma unroll
        for (int ai = 0; ai < 2; ++ai) {
#pragma unroll
            for (int m = 0; m < 4; ++m) { const int row = row0 + ai * HALF + m * 16;
#pragma unroll
                for (int bj = 0; bj < 2; ++bj) { f32x4 r0, r1; ratio8(row, col0 + bj * HALF, z, r0, r1); acc[ai][bj][m][0] = acc[ai][bj][m][0] * r0; acc[ai][bj][m][1] = acc[ai][bj][m][1] * r1; } }
#pragma unroll
            for (int m = 0; m < 4; ++m) asm volatile("" : "+v"(acc[ai][0][m][0]), "+v"(acc[ai][0][m][1]), "+v"(acc[ai][1][m][0]), "+v"(acc[ai][1][m][1]) :: "memory"); }
        if (u.xrow >= 0) { f32x4 r0, r1; ratio8(u.xrow + fr, u.pn * BM + wr * HALF + wc * 32 + 8 * fq, z, r0, r1); accx[0] = accx[0] * r0; accx[1] = accx[1] * r1; }
    }
    __device__ __forceinline__ void put8(int row, int col, const f32x4 a0, const f32x4 a1) const {
        put8v(row, col, a0, a1, *(const u32x4*)(Z + ((unsigned)row * (unsigned)NIN + (unsigned)(ZC_G + D * 2 + col)))); }
    __device__ __forceinline__ void put8v(int row, int col, const f32x4 a0, const f32x4 a1, const u32x4 gw) const {
        f32x4 g0, g1; g0[0] = bf_lo(gw.x); g0[1] = bf_hi(gw.x); g0[2] = bf_lo(gw.y); g0[3] = bf_hi(gw.y); g1[0] = bf_lo(gw.z); g1[1] = bf_hi(gw.z); g1[2] = bf_lo(gw.w); g1[3] = bf_hi(gw.w);
        const f32x4 v0 = g0 * a0, v1 = g1 * a1;
        u32x4 w; w.x = cvt_pk_bf16(v0[0], v0[1]); w.y = cvt_pk_bf16(v0[2], v0[3]); w.z = cvt_pk_bf16(v1[0], v1[1]); w.w = cvt_pk_bf16(v1[2], v1[3]);
        *(u32x4*)(MB + ((unsigned)row * (unsigned)D + (unsigned)col)) = w; }
    __device__ __forceinline__ void operator()(const f32x4 (&acc)[2][2][4][2], const Unit& u, int wr, int wc, int fr, int fq, const unsigned (&)[8]) const {
        const int row0 = u.pm * BM + wr * 64 + fr, col0 = u.pn * BM + wc * 32 + 8 * fq;
        u32x4 gr_[4][2];
#define EB_ROW(G) (row0 + ((G) >> 2) * HALF + ((G) & 3) * 16)
#define EB_LOAD(G) do { gr_[(G) & 3][0] = *(const u32x4*)(Z + ((unsigned)EB_ROW(G) * (unsigned)NIN + (unsigned)(ZC_G + D * 2 + col0))); \
                        gr_[(G) & 3][1] = *(const u32x4*)(Z + ((unsigned)EB_ROW(G) * (unsigned)NIN + (unsigned)(ZC_G + D * 2 + col0 + HALF))); } while (0)
        EB_LOAD(0); EB_LOAD(1); EB_LOAD(2);
#pragma unroll
        for (int g = 0; g < 8; ++g) { const int ai = g >> 2, m = g & 3, row = EB_ROW(g);
            if (g + 3 < 8) EB_LOAD(g + 3);
            put8v(row, col0, acc[ai][0][m][0], acc[ai][0][m][1], gr_[g & 3][0]); put8v(row, col0 + HALF, acc[ai][1][m][0], acc[ai][1][m][1], gr_[g & 3][1]);
            asm volatile("" ::: "memory"); }
#undef EB_LOAD
#undef EB_ROW
    }
    __device__ __forceinline__ void extra(const f32x4 (&accx)[2], const Unit& u, int wr, int wc, int fr, int fq) const {
        put8(u.xrow + fr, u.pn * BM + wr * HALF + wc * 32 + 8 * fq, accx[0], accx[1]);
    }
};
struct EpiWeff {
    static constexpr bool PERM = true, HOOK = false, PRE = false;
    __device__ __forceinline__ void pre(const Unit&, int, int, unsigned (&)[8]) const {}
    bf16_t* WS;
    __device__ __forceinline__ void operator()(const f32x4 (&acc)[2][2][4][2], const Unit& u, int wr, int wc, int fr, int fq, const unsigned (&)[8]) const {
        const int layer = u.pz >> 2, g = u.pz & 3;
        bf16_t* O = (bf16_t*)((char*)WS + (size_t)layer * LW_STRIDE) + g * 256;
        const int row0 = u.pm * BM + wr * 64 + fr, col = wc * 32 + 8 * fq;
#pragma unroll
        for (int ai = 0; ai < 2; ++ai)
#pragma unroll
            for (int m = 0; m < 4; ++m) { const int row = row0 + ai * HALF + m * 16;
#pragma unroll
                for (int bj = 0; bj < 2; ++bj) { const f32x4 v0 = acc[ai][bj][m][0], v1 = acc[ai][bj][m][1];
                    u32x4 w; w.x = cvt_pk_bf16(v0[0], v0[1]); w.y = cvt_pk_bf16(v0[2], v0[3]); w.z = cvt_pk_bf16(v1[0], v1[1]); w.w = cvt_pk_bf16(v1[2], v1[3]);
                    *(u32x4*)(O + (size_t)row * NBR + col + bj * HALF) = w; } }
    }
};

constexpr int XOFF = RING_BYTES + 2048;
template <bool XR, class Epi, class Sched>
__device__ __forceinline__ void gemm_phase(LAS unsigned char* lds, const Gemm g, const Sched& S, const Epi& E) {
    int tid = threadIdx.x; asm volatile("" : "+v"(tid));
    const int wid = __builtin_amdgcn_readfirstlane(tid >> 6), lane = tid & 63, wr = wid >> 2, wc = wid & 3, fr = lane & 15, fq = lane >> 4;
    int nt = g.K / BK; asm volatile("" : "+s"(nt));
    unsigned voffA, voffB, voffX = 0;
    { int R, C; stage_rc(tid * 16, R, C); const int Rb = Epi::PERM ? ((R & ~31) + perm32(R & 31)) : R;
      voffA = (unsigned)(R * g.lda + C) * 2u; voffB = (unsigned)(Rb * g.ldb + C) * 2u; }
    const size_t r64A = (size_t)64 * g.lda * 2, r64B = (size_t)64 * g.ldb * 2;
    if (XR) { int R, C; stage_rc(tid * 4, R, C); voffX = (unsigned)(R * g.lda + C) * 2u; }
    const size_t kstep = (size_t)(BK * 2);
    const size_t hstepA = (size_t)HALF * g.lda * 2, hstepB = (size_t)HALF * g.ldb * 2;
    const unsigned ldsw = (unsigned)wid * 1024u;
    const int aoff = lds_byte(wr * 64 + fr, fq * 8), boff = lds_byte(wc * 32 + fr, fq * 8), xoffr = lds_byte(fr, fq * 8);
#define PG8_SA(b, h) (((b) * 2 + (h)) * HTB)
#define PG8_SB(b, h) ((4 + (b) * 2 + (h)) * HTB)
#define PG8_STAGE(bufoff, gbase, voff) do { _Pragma("unroll") for (int _i = 0; _i < 2; ++_i) \
        __builtin_amdgcn_global_load_lds((const unsigned*)((const char*)(gbase) + (_i ? PG8_R64_##voff : (size_t)0) + (voff)), (LAS unsigned*)(lds + (bufoff) + ldsw + _i * 8192), 16, 0, 0); } while (0)
#define PG8_R64_voffA r64A
#define PG8_R64_voffB r64B
#define PG8_STAGEX(b, gbase) do { if (XR) __builtin_amdgcn_global_load_lds((const unsigned*)((const char*)(gbase) + voffX), (LAS unsigned*)(lds + XOFF + (b) * 2048 + (unsigned)wid * 256u), 4, 0, 0); } while (0)
#define PG8_LDA(dst, b, h) do { _Pragma("unroll") for (int m = 0; m < 4; ++m) _Pragma("unroll") for (int k = 0; k < 2; ++k) dst[m][k] = *(const LAS bf16x8*)(lds + PG8_SA(b, h) + aoff + m * 2048 + k * 1024); } while (0)
#define PG8_LDB(dst, b, h) do { _Pragma("unroll") for (int n = 0; n < 2; ++n) _Pragma("unroll") for (int k = 0; k < 2; ++k) dst[n][k] = *(const LAS bf16x8*)(lds + PG8_SB(b, h) + boff + n * 2048 + k * 1024); } while (0)
#define PG8_LDX(b) do { if (XR && hasx) { _Pragma("unroll") for (int k = 0; k < 2; ++k) Ax[k] = *(const LAS bf16x8*)(lds + XOFF + (b) * 2048 + xoffr + k * 1024); } } while (0)
#define PG8_MMA(ai, bj, At, Bt) do { __builtin_amdgcn_s_setprio(1); _Pragma("unroll") for (int m = 0; m < 4; ++m) _Pragma("unroll") for (int n = 0; n < 2; ++n) _Pragma("unroll") for (int k = 0; k < 2; ++k) \
        acc[ai][bj][m][n] = __builtin_amdgcn_mfma_f32_16x16x32_bf16(Bt[n][k], At[m][k], acc[ai][bj][m][n], 0, 0, 0); __builtin_amdgcn_s_setprio(0); } while (0)
#define PG8_MMAX() do { if (XR && hasx) { if (wr == 0) { _Pragma("unroll") for (int n = 0; n < 2; ++n) _Pragma("unroll") for (int k = 0; k < 2; ++k) accx[n] = __builtin_amdgcn_mfma_f32_16x16x32_bf16(B0[n][k], Ax[k], accx[n], 0, 0, 0); } \
        else { _Pragma("unroll") for (int n = 0; n < 2; ++n) _Pragma("unroll") for (int k = 0; k < 2; ++k) accx[n] = __builtin_amdgcn_mfma_f32_16x16x32_bf16(B1[n][k], Ax[k], accx[n], 0, 0, 0); } } } while (0)
#define PG8_WAIT_V(n) asm volatile("s_waitcnt vmcnt(" #n ")" ::: "memory")
#define PG8_WAIT_VL() do { if (XR) PG8_WAIT_V(9); else PG8_WAIT_V(8); } while (0)
#define PG8_WAIT_L(n) asm volatile("s_waitcnt lgkmcnt(" #n ")" ::: "memory")
#define PG8_BAR __builtin_amdgcn_s_barrier()
#define PG8_SCHED __builtin_amdgcn_sched_barrier(0)
    Unit cur, nxt; int ui = 0;
    if (!S.next(0, cur)) return;
    f32x4 acc[2][2][4][2], accx[2];
#pragma unroll
    for (int a = 0; a < 2; ++a)
#pragma unroll
        for (int b = 0; b < 2; ++b)
#pragma unroll
            for (int m = 0; m < 4; ++m)
#pragma unroll
                for (int n = 0; n < 2; ++n) acc[a][b][m][n] = (f32x4){0.f, 0.f, 0.f, 0.f};
    accx[0] = (f32x4){0.f, 0.f, 0.f, 0.f}; accx[1] = (f32x4){0.f, 0.f, 0.f, 0.f};
    bf16x8 At[4][2], B0[2][2], B1[2][2], Ax[2]; unsigned rq[8] = {0, 0, 0, 0, 0, 0, 0, 0};
    const char* cA = (const char*)(g.A + cur.aoff); const char* cB = (const char*)(g.Bt + cur.boff); const char* cX = (const char*)(g.A + cur.xoff);
    PG8_STAGE(PG8_SB(0, 0), cB, voffB); PG8_STAGE(PG8_SB(0, 1), cB + hstepB, voffB); PG8_STAGE(PG8_SA(0, 0), cA, voffA); PG8_STAGEX(0, cX); PG8_STAGE(PG8_SA(0, 1), cA + hstepA, voffA);
    if (wr == 1) PG8_BAR;
    PG8_WAIT_V(2); PG8_BAR;
    PG8_STAGE(PG8_SB(1, 0), cB + kstep, voffB); PG8_STAGE(PG8_SA(1, 0), cA + kstep, voffA); PG8_STAGE(PG8_SB(1, 1), cB + hstepB + kstep, voffB); PG8_STAGEX(1, cX + kstep);
    if (XR) PG8_WAIT_V(7); else PG8_WAIT_V(6);
    PG8_BAR;
    for (;;) {
        const bool has_next = S.next(ui + 1, nxt);
        const char* nA = has_next ? (const char*)(g.A + nxt.aoff) : cA; const char* nB = has_next ? (const char*)(g.Bt + nxt.boff) : cB; const char* nX = has_next ? (const char*)(g.A + nxt.xoff) : cX;
        const bool hasx = XR && cur.xrow >= 0;
        for (int t = 0; t < nt; t += 2) {
            const bool last = (t == nt - 2);
            const char* a1 = cA + (size_t)(t + 1) * kstep;
            const char* a2 = last ? nA : cA + (size_t)(t + 2) * kstep; const char* b2 = last ? nB : cB + (size_t)(t + 2) * kstep; const char* x2 = last ? nX : cX + (size_t)(t + 2) * kstep;
            const char* a3 = a2 + kstep; const char* b3 = b2 + kstep; const char* x3 = x2 + kstep;
            if constexpr (Epi::PRE) { if (last) { int tz = threadIdx.x; asm volatile("" : "+v"(tz)); const int wz = __builtin_amdgcn_readfirstlane(tz >> 6); E.pre(cur, wz >> 2, tz & 15, rq); } }
            if constexpr (Epi::HOOK) { if (E.hook_at(t)) { int tz = threadIdx.x; asm volatile("" : "+v"(tz));
                const int wz = __builtin_amdgcn_readfirstlane(tz >> 6); E.mid(acc, accx, cur, t, wz >> 2, wz & 3, tz & 15, (tz & 63) >> 4); } }
            PG8_LDB(B0, 0, 0); PG8_LDB(B1, 0, 1); PG8_SCHED; PG8_LDA(At, 0, 0); PG8_LDX(0); PG8_STAGE(PG8_SA(1, 1), a1 + hstepA, voffA);
            PG8_WAIT_VL(); PG8_WAIT_L(0); PG8_BAR; PG8_MMA(0, 0, At, B0); PG8_MMA(0, 1, At, B1); PG8_MMAX(); PG8_BAR; PG8_SCHED;
            PG8_LDA(At, 0, 1); PG8_STAGE(PG8_SB(0, 0), b2, voffB); PG8_STAGE(PG8_SB(0, 1), b2 + hstepB, voffB); PG8_STAGE(PG8_SA(0, 0), a2, voffA); PG8_STAGEX(0, x2);
            PG8_WAIT_VL(); PG8_WAIT_L(0); PG8_BAR; PG8_MMA(1, 0, At, B0); PG8_MMA(1, 1, At, B1); PG8_BAR; PG8_SCHED;
            PG8_LDB(B0, 1, 0); PG8_LDB(B1, 1, 1); PG8_SCHED; PG8_LDA(At, 1, 0); PG8_LDX(1); PG8_STAGE(PG8_SA(0, 1), a2 + hstepA, voffA);
            PG8_WAIT_VL(); PG8_WAIT_L(0); PG8_BAR; PG8_MMA(0, 0, At, B0); PG8_MMA(0, 1, At, B1); PG8_MMAX(); PG8_BAR; PG8_SCHED;
            PG8_LDA(At, 1, 1); PG8_STAGE(PG8_SB(1, 0), b3, voffB); PG8_STAGE(PG8_SB(1, 1), b3 + hstepB, voffB); PG8_STAGE(PG8_SA(1, 0), a3, voffA); PG8_STAGEX(1, x3);
            PG8_WAIT_VL(); PG8_WAIT_L(0); PG8_BAR; PG8_MMA(1, 0, At, B0); PG8_MMA(1, 1, At, B1); PG8_BAR; PG8_SCHED;
        }
        if (wr == 0) PG8_BAR;
        { int tz = threadIdx.x; asm volatile("" : "+v"(tz)); const int wz = __builtin_amdgcn_readfirstlane(tz >> 6), ewr = wz >> 2, ewc = wz & 3, efr = tz & 15, efq = (tz & 63) >> 4;
          E(acc, cur, ewr, ewc, efr, efq, rq);
          if constexpr (XR) { if (cur.xrow >= 0) E.extra(accx, cur, ewr, ewc, efr, efq); } }
        if (!has_next) break;
#pragma unroll
        for (int a = 0; a < 2; ++a)
#pragma unroll
            for (int b = 0; b < 2; ++b)
#pragma unroll
                for (int m = 0; m < 4; ++m)
#pragma unroll
                    for (int n = 0; n < 2; ++n) acc[a][b][m][n] = (f32x4){0.f, 0.f, 0.f, 0.f};
        accx[0] = (f32x4){0.f, 0.f, 0.f, 0.f}; accx[1] = (f32x4){0.f, 0.f, 0.f, 0.f};
        cur = nxt; cA = nA; cB = nB; cX = nX; ++ui;
        if (wr == 1) PG8_BAR;
    }
    PG8_WAIT_V(0);
    PG8_BAR;
#undef PG8_SA
#undef PG8_SB
#undef PG8_STAGE
#undef PG8_R64_voffA
#undef PG8_R64_voffB
#undef PG8_STAGEX
#undef PG8_LDA
#undef PG8_LDB
#undef PG8_LDX
#undef PG8_MMA
#undef PG8_MMAX
#undef PG8_WAIT_V
#undef PG8_WAIT_VL
#undef PG8_WAIT_L
#undef PG8_BAR
#undef PG8_SCHED
}
}

#define XB_TMO      128
#define XB_XCNT(j)  (256  + 64 * (j))
#define XB_XSUB(j)  (1280 + 64 * (j))
#define XB_XGEN(j)  (2304 + 64 * (j))
#define XB_TOP      3328
#define XB_TOPGEN   3392
#define XCD_BAR_WORDS 3456
#define XB_SPIN_CAP (1u << 18)
__device__ __forceinline__ unsigned xb_ld(unsigned* p)              { return __hip_atomic_load(p, __ATOMIC_RELAXED, __HIP_MEMORY_SCOPE_AGENT); }
__device__ __forceinline__ unsigned xb_add(unsigned* p, unsigned v) { return __hip_atomic_fetch_add(p, v, __ATOMIC_RELAXED, __HIP_MEMORY_SCOPE_AGENT); }
__device__ __forceinline__ unsigned xb_xcc_id() { return (unsigned)__builtin_amdgcn_s_getreg((3 << 11) | 20) & 0xFu; }
#define XB_SPIN(cond, bar) do { unsigned _sp = 0; while (cond) { __builtin_amdgcn_s_sleep(1); \
    if ((++_sp & 255u) == 0u) { if (xb_ld(&(bar)[XB_TMO])) break; if (_sp > XB_SPIN_CAP) { atomicAdd(&(bar)[XB_TMO], 1u); break; } } } } while (0)
struct XcdBarrier { unsigned* bar; unsigned x; volatile LAS unsigned* st; };
__device__ __forceinline__ XcdBarrier xcd_barrier_post(unsigned* bar, volatile LAS unsigned* st) {
    XcdBarrier b; b.bar = bar; b.x = xb_xcc_id(); b.st = st;
    if (threadIdx.x == 0) (void)xb_add(&bar[XB_XCNT(b.x)], 1u);
    return b;
}
__device__ __forceinline__ void xcd_barrier_complete(unsigned* bar, unsigned x, unsigned& nloc, unsigned& nx) {
    const unsigned G = gridDim.x * gridDim.y * gridDim.z;
    unsigned sum, cnt, mine, sp = 0u;
    for (;;) {
        sum = 0u; cnt = 0u; mine = 0u;
#pragma unroll
        for (unsigned j = 0; j < 16; ++j) { const unsigned c = xb_ld(&bar[XB_XCNT(j)]); sum += c; cnt += (c > 0u) ? 1u : 0u; mine = (j == x) ? c : mine; }
        if (sum == G) break;
        __builtin_amdgcn_s_sleep(1);
        if ((++sp & 255u) == 0u) { if (xb_ld(&bar[XB_TMO])) break; if (sp > XB_SPIN_CAP) { atomicAdd(&bar[XB_TMO], 1u); break; } }
    }
    nloc = mine > 0u ? mine : 1u; nx = cnt > 0u ? cnt : 1u;
}
__device__ __forceinline__ void xcd_barrier(const XcdBarrier& b) {
    asm volatile("s_waitcnt vmcnt(0)" ::: "memory");
    __syncthreads();
    if (threadIdx.x == 0) {
        unsigned* bar = b.bar;
        __builtin_amdgcn_s_waitcnt(0);
        unsigned nloc = b.st[0], nx = b.st[1];
        if (nloc == 0u) { xcd_barrier_complete(bar, b.x, nloc, nx); b.st[0] = nloc; b.st[1] = nx; }
        const unsigned old = xb_add(&bar[XB_XSUB(b.x)], 1u);
        const unsigned gen = old / nloc;
        if (old + 1u == (gen + 1u) * nloc) {
            __builtin_amdgcn_fence(__ATOMIC_RELEASE, "agent");
            asm volatile("s_waitcnt vmcnt(0)" ::: "memory");
            const unsigned og = xb_add(&bar[XB_TOP], 1u);
            const unsigned tg = og / nx;
            if (og + 1u == (tg + 1u) * nx) xb_add(&bar[XB_TOPGEN], 1u);
            else XB_SPIN(xb_ld(&bar[XB_TOPGEN]) == tg, bar);
            __builtin_amdgcn_fence(__ATOMIC_ACQUIRE, "agent");
            xb_add(&bar[XB_XGEN(b.x)], 1u);
            asm volatile("s_waitcnt vmcnt(0)" ::: "memory");
        } else {
            XB_SPIN(xb_ld(&bar[XB_XGEN(b.x)]) == gen, bar);
            __builtin_amdgcn_fence(__ATOMIC_ACQUIRE, "agent");
            asm volatile("s_waitcnt vmcnt(0)" ::: "memory");
        }
    }
    __syncthreads();
}

struct Args { const float* in[31]; float* out; unsigned char* ws; int ph_lo, ph_hi; };
static_assert(sizeof(Args) == 31 * 8 + 8 + 8 + 8, "Args has no padding");

struct Ctx {
    const float* const* tbl; unsigned char* ws; float* out; int l;
    __device__ __forceinline__ const GAS float* in(int i) const { return (const GAS float*)tbl[i]; }
    __device__ __forceinline__ const bf16_t* Z() const { return (const bf16_t*)(ws + WS_Z); }
    __device__ __forceinline__ bf16_t* BR() const { return (bf16_t*)(ws + WS_BR); }
    __device__ __forceinline__ const float* rope() const { return (const float*)(ws + WS_ROPE); }
    __device__ __forceinline__ float* summ() const { return (float*)(ws + WS_SUMM); }
    __device__ __forceinline__ const GAS float* qn() const { return in(14) + l * 64; }
    __device__ __forceinline__ const GAS float* kn() const { return in(15) + l * 64; }
    __device__ __forceinline__ const GAS float* sinks() const { return in(16) + l * 16; }
    __device__ __forceinline__ const GAS float* cache_k() const { return in(3) + (size_t)l * 32 * 128 * 256; }
    __device__ __forceinline__ const GAS float* cache_v() const { return in(4) + (size_t)l * 32 * 128 * 256; }
    __device__ __forceinline__ const GAS float* state_pool() const { return in(2) + (size_t)l * 32 * 15 * 1024; }
    __device__ __forceinline__ const GAS float* state_conv() const { return in(5) + (size_t)l * 32 * 3 * 1024; }
    __device__ __forceinline__ const GAS float* state_h() const { return in(6) + (size_t)l * 32 * 1024; }
    __device__ __forceinline__ const GAS float* conv_w() const { return in(17) + l * 4096; }
    __device__ __forceinline__ const GAS float* conv_b() const { return in(18) + l * 1024; }
    __device__ __forceinline__ const GAS float* ba() const { return in(20) + l * 1024; }
    __device__ __forceinline__ const GAS float* bx() const { return in(22) + l * 1024; }
    __device__ __forceinline__ const GAS float* lam() const { return in(23) + l * 1024; }
    __device__ __forceinline__ const bf16_t* WaT() const { return (const bf16_t*)(ws + WS_GATE) + (size_t)(l * 2 + 0) * 65536; }
    __device__ __forceinline__ const bf16_t* WxT() const { return (const bf16_t*)(ws + WS_GATE) + (size_t)(l * 2 + 1) * 65536; }
    __device__ __forceinline__ float* o_pool(int sample) const { return out + (sample ? O_POOL_S + (size_t)l * 32 * 15 * 1024 : O_POOL_P + (size_t)l * 4 * 15 * 1024); }
    __device__ __forceinline__ float* o_k(int sample) const { return out + (sample ? O_K_S + (size_t)l * 32 * 128 * 256 : O_K_P + (size_t)l * 4 * 128 * 256); }
    __device__ __forceinline__ float* o_v(int sample) const { return out + (sample ? O_V_S + (size_t)l * 32 * 128 * 256 : O_V_P + (size_t)l * 4 * 128 * 256); }
    __device__ __forceinline__ float* o_conv(int sample) const { return out + (sample ? O_CONV_S + (size_t)l * 32 * 3 * 1024 : O_CONV_P + (size_t)l * 4 * 3 * 1024); }
    __device__ __forceinline__ float* o_h(int sample) const { return out + (sample ? O_H_S + (size_t)l * 32 * 1024 : O_H_P + (size_t)l * 4 * 1024); }
};

struct TDesc { const GAS float* src; const GAS float* gain; GAS bf16_t* dst; int ldw, ldo; };
__device__ __forceinline__ int gu_rowmap(int n0) { return n0 < FF ? 256 * (n0 >> 7) + (n0 & 127) : 256 * ((n0 - FF) >> 7) + 128 + ((n0 - FF) & 127); }
constexpr int TT_GU = (D / 64) * (NGU / 64), TT_DN = (FF / 64) * (D / 64), TT_IN = (D / 64) * (NIN / 64), TT_BR = (1024 / 64) * (D / 64), TT_OUT = (D / 64) * (D / 64), TT_GT = 32;
constexpr int TT_LAYER = 2 * TT_GU + 2 * TT_DN + TT_IN + 3 * TT_BR + TT_OUT + TT_GT;
struct PSArgs { const Args* a; __device__ __forceinline__ const float* operator()(int i) const { return a->in[i]; } };
struct PSTbl { const float* const* t; __device__ __forceinline__ const float* operator()(int i) const { return (const float*)(const GAS float*)t[i]; } };
constexpr int TT_STREAM = TT_LAYER - TT_BR, TT_B0 = DEPTH * TT_BR, TT_TOTAL = TT_B0 + DEPTH * TT_STREAM;
__host__ __device__ constexpr int tt_need(int l, int j) {
    int c = TT_GU; if (j >= 1) c += TT_DN; if (j >= 2) c += TT_IN; if (j >= 3) c += TT_GT + 2 * TT_BR; if (j >= 5) c += TT_OUT; if (j >= 6) c += TT_GU; if (j >= 7) c += TT_DN;
    return TT_B0 + l * TT_STREAM + c; }
static_assert(tt_need(DEPTH - 1, 7) == TT_TOTAL, "tile stream");
template <class PS>
__device__ __forceinline__ TDesc tr_decode(const PS& P, unsigned char* ws, int it) {
    TDesc d; d.gain = nullptr;
#define TT_SET(SRC, LDW, DST, LDO, OROW, OCOL, K0, N0) do { d.src = (const GAS float*)((SRC) + (size_t)(K0) * (LDW) + (N0)); d.ldw = (LDW); d.dst = (GAS bf16_t*)((DST) + (size_t)(OROW) * (LDO) + (OCOL) + (K0)); d.ldo = (LDO); } while (0)
    if (it < TT_B0) { const int l = it / TT_BR, r = it - l * TT_BR; const int kb = r / (D / 64), nb = r - kb * (D / 64);
        TT_SET(P(24) + (size_t)l * 1024 * D, D, (bf16_t*)(ws + WS_WBPT) + (size_t)l * D * 1024, 1024, 64 * nb, 0, 64 * kb, 64 * nb); return d; }
    it -= TT_B0;
    const int l = it / TT_STREAM; int r = it - l * TT_STREAM;
    unsigned char* lw = ws + WS_W + (size_t)l * LW_STRIDE;
    if (r < TT_GU) { const int kb = r / (NGU / 64), nb = r - kb * (NGU / 64); TT_SET(P(8) + (size_t)l * D * NGU, NGU, (bf16_t*)(lw + LW_GUA), D, gu_rowmap(64 * nb), 0, 64 * kb, 64 * nb); d.gain = (const GAS float*)(P(7) + l * D + 64 * kb); return d; } r -= TT_GU;
    if (r < TT_DN) { const int kb = r / (D / 64), nb = r - kb * (D / 64); TT_SET(P(9) + (size_t)l * FF * D, D, (bf16_t*)(lw + LW_DNA), FF, 64 * nb, 0, 64 * kb, 64 * nb); return d; } r -= TT_DN;
    if (r < TT_IN) { const int kb = r / (NIN / 64), nb = r - kb * (NIN / 64); TT_SET(P(11) + (size_t)l * D * NIN, NIN, (bf16_t*)(lw + LW_IN), D, 64 * nb, 0, 64 * kb, 64 * nb); d.gain = (const GAS float*)(P(10) + l * D + 64 * kb); return d; } r -= TT_IN;
    if (r < TT_GT) { const int gate = r >> 4, h = r & 15; TT_SET(P(gate ? 21 : 19) + (size_t)l * 65536 + h * 4096, 64, (bf16_t*)(ws + WS_GATE) + (size_t)((l * 2 + gate) * 16 + h) * 4096, 64, 0, 0, 0, 0); return d; } r -= TT_GT;
    if (r < TT_BR) { const int kb = r / (D / 64), nb = r - kb * (D / 64); TT_SET(P(25) + (size_t)l * 1024 * D, D, (bf16_t*)(lw + LW_CAT), NBR, 64 * nb, BRC_ATT, 64 * kb, 64 * nb); return d; } r -= TT_BR;
    if (r < TT_BR) { const int kb = r / (D / 64), nb = r - kb * (D / 64); TT_SET(P(26) + (size_t)l * 1024 * D, D, (bf16_t*)(lw + LW_CAT), NBR, 64 * nb, BRC_LRU, 64 * kb, 64 * nb); return d; } r -= TT_BR;
    if (r < TT_OUT) { const int kb = r / (D / 64), nb = r - kb * (D / 64); TT_SET(P(27) + (size_t)l * D * D, D, (bf16_t*)(lw + LW_OUT), D, 64 * nb, 0, 64 * kb, 64 * nb); return d; } r -= TT_OUT;
    if (r < TT_GU) { const int kb = r / (NGU / 64), nb = r - kb * (NGU / 64); TT_SET(P(29) + (size_t)l * D * NGU, NGU, (bf16_t*)(lw + LW_GUB), D, gu_rowmap(64 * nb), 0, 64 * kb, 64 * nb); d.gain = (const GAS float*)(P(28) + l * D + 64 * kb); return d; } r -= TT_GU;
    { const int kb = r / (D / 64), nb = r - kb * (D / 64); TT_SET(P(30) + (size_t)l * FF * D, D, (bf16_t*)(lw + LW_DNB), FF, 64 * nb, 0, 64 * kb, 64 * nb); }
#undef TT_SET
    return d;
}
__device__ __forceinline__ void tr_load(const TDesc& d, f32x4 (&v)[16], int lane) {
    const GAS float* p = d.src + (size_t)(2 * (lane >> 4)) * d.ldw + 4 * (lane & 15);
#pragma unroll
    for (int i = 0; i < 8; ++i) { v[2 * i] = *(const GAS f32x4*)(p + (size_t)(8 * i) * d.ldw); v[2 * i + 1] = *(const GAS f32x4*)(p + (size_t)(8 * i + 1) * d.ldw); }
}
__device__ __forceinline__ void tr_store(const TDesc& d, const f32x4 (&v)[16], LAS unsigned char* img, int lane) {
    const int n4 = lane & 15, kpl = lane >> 4;
#pragma unroll
    for (int i = 0; i < 8; ++i) { float g0 = 1.f, g1 = 1.f; if (d.gain) { g0 = d.gain[2 * (kpl + 4 * i)]; g1 = d.gain[2 * (kpl + 4 * i) + 1]; }
#pragma unroll
        for (int e = 0; e < 4; ++e) *(LAS unsigned*)(img + (4 * n4 + e) * 128 + ((i ^ (n4 & 7)) << 4) + kpl * 4) = cvt_pk_bf16(v[2 * i][e] * g0, v[2 * i + 1][e] * g1); }
    LDS_WAIT();
#pragma unroll
    for (int j = 0; j < 8; ++j) { const int idx = lane + 64 * j, n = idx >> 3, c = idx & 7;
        const u32x4 w = *(const LAS u32x4*)(img + n * 128 + ((c ^ ((n >> 2) & 7)) << 4));
        *(GAS u32x4*)(d.dst + (size_t)n * d.ldo + 8 * c) = w; }
    LDS_WAIT();
}


constexpr int CW_SPTR = 1024;
constexpr int TT_BASE0 = tt_need(0, 0);
template <class PS>
__device__ __forceinline__ void convert_range(const PS& P, unsigned char* ws, LAS unsigned char* img, int lane, int r0, int r1, int widx, int nw) {
    int it = r0 + widx; f32x4 va[16], vb[16]; TDesc da, db;
    if (it < r1) { da = tr_decode(P, ws, it); tr_load(da, va, lane); }
    while (it < r1) {
        const int it1 = it + nw; if (it1 < r1) { db = tr_decode(P, ws, it1); tr_load(db, vb, lane); }
        tr_store(da, va, img, lane);
        if (it1 >= r1) break;
        const int it2 = it1 + nw; if (it2 < r1) { da = tr_decode(P, ws, it2); tr_load(da, va, lane); }
        tr_store(db, vb, img, lane);
        it = it2; }
}
template <class PS>
__device__ __forceinline__ void convert_wg(const PS& P, unsigned char* ws, LAS unsigned char* lds, volatile LAS unsigned* st, unsigned* sp, int bound, int fixed) {
    int tz = threadIdx.x; asm volatile("" : "+v"(tz)); const int wz = __builtin_amdgcn_readfirstlane(tz >> 6), lz = tz & 63;
#pragma unroll 1
    for (;;) {
        if (tz == 0) { int base = -1, n = 0; const int cur = TT_BASE0 + (int)__hip_atomic_load(sp, __ATOMIC_RELAXED, __HIP_MEMORY_SCOPE_AGENT);
            if (cur < bound) { const int G_ = (int)gridDim.x; int want = fixed > 0 ? fixed : (bound - cur + G_ - 1) / G_; want = (want + 7) & ~7; n = want < 8 ? 8 : (want > 64 ? 64 : want);
                base = TT_BASE0 + (int)__hip_atomic_fetch_add(sp, (unsigned)n, __ATOMIC_RELAXED, __HIP_MEMORY_SCOPE_AGENT); }
            st[3] = (unsigned)base; st[4] = (unsigned)n; }
        __syncthreads();
        const int base = __builtin_amdgcn_readfirstlane((int)st[3]), n = __builtin_amdgcn_readfirstlane((int)st[4]);
        __syncthreads();
        if (base < 0 || base >= TT_TOTAL) break;
        const int end = (base + n) < TT_TOTAL ? (base + n) : TT_TOTAL;
        convert_range(P, ws, lds + wz * 8192, lz, base, end, wz, 8);
        if (fixed > 0) break;
    }
}
__device__ __forceinline__ void prologue(const Args& a, LAS unsigned char* lds, int gw, int NGW, int wave, int lane) {
    unsigned char* ws = a.ws;
    LAS unsigned char* img = lds + wave * 8192;
    if (gw == 0 && lane < 31) { const float* p = a.in[0];
#pragma unroll
        for (int q = 1; q < 31; ++q) p = (lane == q) ? a.in[q] : p;
        ((const float**)(ws + WS_TBL))[lane] = p; }
    { const PSArgs P{&a};
      convert_range(P, ws, img, lane, 0, TT_BASE0, gw, NGW); }
    { bf16_t* pp = (bf16_t*)(ws + WS_PP);
      for (int i = gw * 64 + lane; i < DEPTH * 4 * 65536 / 8; i += NGW * 64) { const int e = i * 8, lg = e >> 16, d0 = e & 255; const float* w = a.in[12] + e; const float* sc = a.in[13] + lg * 256 + d0;
          const f32x4 w0 = *(const f32x4*)w, w1 = *(const f32x4*)(w + 4), s0 = *(const f32x4*)sc, s1 = *(const f32x4*)(sc + 4);
          u32x4 o; o.x = cvt_pk_bf16(w0[0] * s0[0], w0[1] * s0[1]); o.y = cvt_pk_bf16(w0[2] * s0[2], w0[3] * s0[3]); o.z = cvt_pk_bf16(w1[0] * s1[0], w1[1] * s1[1]); o.w = cvt_pk_bf16(w1[2] * s1[2], w1[3] * s1[3]);
          *(u32x4*)(pp + e) = o; } }
    { bf16_t* XB = (bf16_t*)(ws + WS_XB); u64* ss0 = (u64*)(ws + WS_CTL + (size_t)CW_SS * 4);
      for (int row = gw; row < M; row += NGW) { const float* src = row < MP ? a.in[0] + (size_t)row * D : a.in[1] + (size_t)(row - MP) * D; float s = 0.f;
#pragma unroll
          for (int j = 0; j < 8; ++j) { const int c = 4 * lane + 256 * j; const f32x4 v = *(const f32x4*)(src + c);
              u32x2 w; w.x = cvt_pk_bf16(v[0], v[1]); w.y = cvt_pk_bf16(v[2], v[3]); *(u32x2*)(XB + (size_t)row * D + c) = w; s += (v[0] * v[0] + v[1] * v[1]) + (v[2] * v[2] + v[3] * v[3]); }
#pragma unroll
          for (int o = 1; o < 64; o <<= 1) s += __shfl_xor(s, o);
          if (lane == 0) ss0[row] = ss_fix(s); } }
    { float* rope = (float*)(ws + WS_ROPE);
      const float inv[8] = {1.0f, 1.939227432e-01f, 3.760603070e-02f, 7.292664610e-03f, 1.414213562e-03f, 2.742481884e-04f, 5.318296098e-05f, 1.031338616e-05f};
      for (int i = gw * 64 + lane; i < 2056 * 8; i += NGW * 64) { const int p = i >> 3, f = i & 7; const int pos = p < 2048 ? p : 16384 + (p - 2048);
          float iv = inv[0];
#pragma unroll
          for (int q = 1; q < 8; ++q) iv = (f == q) ? inv[q] : iv;
          const float ang = (float)pos * iv;
          double rev = (double)ang * 0.15915494309189535; rev -= __builtin_rint(rev);
          const float rv = (float)rev;
          rope[p * 16 + f] = __builtin_amdgcn_cosf(rv); rope[p * 16 + 8 + f] = __builtin_amdgcn_sinf(rv); } }
}

__device__ __forceinline__ void unpack8(const u32x4 w, float (&f)[16], int o) { f[o + 0] = bf_lo(w.x); f[o + 1] = bf_hi(w.x); f[o + 2] = bf_lo(w.y); f[o + 3] = bf_hi(w.y); f[o + 4] = bf_lo(w.z); f[o + 5] = bf_hi(w.z); f[o + 6] = bf_lo(w.w); f[o + 7] = bf_hi(w.w); }

constexpr int KS_STRIDE = 72, VT_STRIDE = 264, VT_OFF = 256 * KS_STRIDE * 2;
template <bool FULL>
__device__ __forceinline__ void attn_compute(const Ctx& C, LAS unsigned char* lds, const bf16_t* Z, int row0, int q0, int nq_, int nspan, int pidx0, int has_past, int kvh, int wid, int lane) {
    const int nq = FULL ? 128 : nq_;
    const int g = wid >> 1, qh = wid & 1, head = kvh * 4 + g, fr = lane & 15, fq = lane >> 4;
    constexpr float LOG2E = 1.4426950408889634f, SC = 0.125f * LOG2E;
    const int smin = has_past ? 0 : ((128 - q0) > 0 ? (128 - q0) : 0), smax = nspan - 1;
    const float sink2 = C.sinks()[head] * LOG2E;
    u32x4 qraw0 = (u32x4){0u, 0u, 0u, 0u}, qraw1 = (u32x4){0u, 0u, 0u, 0u};
    { const int qi0 = 64 * qh + fr; if (64 * qh < nq && qi0 < nq) { const bf16_t* qp = Z + (size_t)(row0 + q0 + qi0) * NIN + ZC_Q + head * 64 + 8 * fq; qraw0 = *(const u32x4*)qp; qraw1 = *(const u32x4*)(qp + 32); } }
#pragma unroll 1
    for (int qp = 0; qp < 2; ++qp) {
    if (!FULL && 64 * qh + 32 * qp >= nq) break;
#pragma unroll
    for (int q2 = 0; q2 < 2; ++q2) { const int qb = 2 * qp + q2;
        if (!FULL && 64 * qh + 16 * qb >= nq) break;
        const int qi = 64 * qh + 16 * qb + fr; const bool qv = qi < nq;
        bf16x8 qf[2];
        { float x[16];
          unpack8(qraw0, x, 0); unpack8(qraw1, x, 8);
          { qraw0 = (u32x4){0u, 0u, 0u, 0u}; qraw1 = (u32x4){0u, 0u, 0u, 0u};
            const int qn_ = qi + 16; if (qb < 3 && 64 * qh + 16 * (qb + 1) < nq && qn_ < nq) { const bf16_t* qp = Z + (size_t)(row0 + q0 + qn_) * NIN + ZC_Q + head * 64 + 8 * fq; qraw0 = *(const u32x4*)qp; qraw1 = *(const u32x4*)(qp + 32); } }
          float ss = 0.f;
#pragma unroll
          for (int j = 0; j < 16; ++j) ss += x[j] * x[j];
          ss = xsum_16_32(ss);
          const float rs = rsqrtf(ss * (1.0f / 64.0f) + RMS_EPS);
#pragma unroll
          for (int j = 0; j < 8; ++j) { x[j] = x[j] * rs * C.qn()[8 * fq + j]; x[8 + j] = x[8 + j] * rs * C.qn()[32 + 8 * fq + j]; }
          const float* rp = C.rope() + (size_t)(pidx0 + q0 + (qv ? qi : 0)) * 16;
#pragma unroll
          for (int j = 0; j < 8; ++j) { const float cs = rp[j], sn = rp[8 + j];
              u32x2v pr = __builtin_amdgcn_permlane16_swap(__float_as_uint(x[j]), __float_as_uint(x[j]), false, false); const float xe = __uint_as_float(pr[0]), xo = __uint_as_float(pr[1]);
              const float r0 = xe * cs - xo * sn, r1 = xo * cs + xe * sn; x[j] = (fq == 0) ? r0 : ((fq == 1) ? r1 : x[j]); }
          u32x4 w0, w1; w0.x = cvt_pk_bf16(x[0], x[1]); w0.y = cvt_pk_bf16(x[2], x[3]); w0.z = cvt_pk_bf16(x[4], x[5]); w0.w = cvt_pk_bf16(x[6], x[7]);
          w1.x = cvt_pk_bf16(x[8], x[9]); w1.y = cvt_pk_bf16(x[10], x[11]); w1.z = cvt_pk_bf16(x[12], x[13]); w1.w = cvt_pk_bf16(x[14], x[15]);
          qf[0] = __builtin_bit_cast(bf16x8, w0); qf[1] = __builtin_bit_cast(bf16x8, w1); }
        const int kbase = 64 * qh + 16 * qb;
        const int lo = qi > smin ? qi : smin, hi = (qi + 128) < smax ? (qi + 128) : smax;
        f32x4 S[9];
#pragma unroll
        for (int kb = 0; kb < 9; ++kb) { S[kb] = (f32x4){0.f, 0.f, 0.f, 0.f};
#pragma unroll
            for (int ks = 0; ks < 2; ++ks) { const bf16x8 kfr = *(const LAS bf16x8*)(lds + (kbase + 16 * kb + fr) * (KS_STRIDE * 2) + (32 * ks + 8 * fq) * 2);
                S[kb] = __builtin_amdgcn_mfma_f32_16x16x32_bf16(kfr, qf[ks], S[kb], 0, 0, 0); } }
        float mx = sink2;
#pragma unroll
        for (int kb = 0; kb < 9; ++kb)
#pragma unroll
            for (int i = 0; i < 4; ++i) { const int sk = kbase + 16 * kb + 4 * fq + i; float v = S[kb][i] * SC; v = (sk >= lo && sk <= hi) ? v : -1e30f; S[kb][i] = v; mx = fmaxf(mx, v); }
        mx = xmax_16_32(mx);
        float lrow = (fq == 0) ? __builtin_amdgcn_exp2f(sink2 - mx) : 0.f;
#pragma unroll
        for (int kb = 0; kb < 9; ++kb)
#pragma unroll
            for (int i = 0; i < 4; ++i) { const float pv = __builtin_amdgcn_exp2f(S[kb][i] - mx); S[kb][i] = pv; lrow += pv; }
        f32x4 O[4];
#pragma unroll
        for (int db = 0; db < 4; ++db) O[db] = (f32x4){0.f, 0.f, 0.f, 0.f};
#pragma unroll
        for (int kk = 0; kk < 5; ++kk) { u32x4 pw; pw.x = cvt_pk_bf16(S[2 * kk][0], S[2 * kk][1]); pw.y = cvt_pk_bf16(S[2 * kk][2], S[2 * kk][3]);
            if (kk < 4) { pw.z = cvt_pk_bf16(S[2 * kk + 1][0], S[2 * kk + 1][1]); pw.w = cvt_pk_bf16(S[2 * kk + 1][2], S[2 * kk + 1][3]); } else { pw.z = 0u; pw.w = 0u; }
            const bf16x8 pf = __builtin_bit_cast(bf16x8, pw);
#pragma unroll
            for (int db = 0; db < 4; ++db) { const LAS unsigned char* vb = lds + VT_OFF + (16 * db + fr) * (VT_STRIDE * 2) + (kbase + 32 * kk + 4 * fq) * 2;
                const u32x2 v0 = *(const LAS u32x2*)vb, v1 = (kk < 4) ? *(const LAS u32x2*)(vb + 32) : v0;
                u32x4 vw; vw.x = v0.x; vw.y = v0.y; vw.z = v1.x; vw.w = v1.y;
                O[db] = __builtin_amdgcn_mfma_f32_16x16x32_bf16(__builtin_bit_cast(bf16x8, vw), pf, O[db], 0, 0, 0); } }
        const float lt = xsum_16_32(lrow); const float inv = 1.0f / lt;
        if (qv) { bf16_t* op = C.BR() + (size_t)(row0 + q0 + qi) * NBR + BRC_ATT + head * 64 + 4 * fq;
#pragma unroll
            for (int db = 0; db < 4; ++db) { const f32x4 o = O[db] * inv; u32x2 w; w.x = cvt_pk_bf16(o[0], o[1]); w.y = cvt_pk_bf16(o[2], o[3]); *(u32x2*)(op + 16 * db) = w; } }
    }
    }
}
__device__ __forceinline__ void attn_unit(const Ctx& C, LAS unsigned char* lds, int a, int tid, int wid, int lane) {
    int T, row0, pidx0, has_past, b, kvh, q0;
    if (a < 256) { b = a >> 6; kvh = (a >> 4) & 3; q0 = (a & 15) * 128; T = 2048; row0 = b * 2048; pidx0 = 0; has_past = 0; }
    else { const int a2 = a - 256; b = a2 >> 2; kvh = a2 & 3; q0 = 0; T = 8; row0 = MP + 8 * b; pidx0 = 2048; has_past = 1; }
    const int nq = (T - q0) < 128 ? (T - q0) : 128, nspan = 128 + nq;
    const bool lastblk = (q0 + nq == T);
    const bf16_t* Z = C.Z();
#pragma unroll 1
    for (int pass = 0; pass < 2; ++pass) {
        const int s = pass * 128 + (tid >> 2), p = tid & 3, tk = q0 - 128 + s;
        float kf[16], vf[16];
#pragma unroll
        for (int j = 0; j < 16; ++j) { kf[j] = 0.f; vf[j] = 0.f; }
        const bool fromz = (s < nspan) && (tk >= 0), frompast = (s < nspan) && (tk < 0) && has_past;
        if (fromz) { const bf16_t* kp = Z + (size_t)(row0 + tk) * NIN + ZC_K + kvh * 64 + p * 16; const bf16_t* vp = Z + (size_t)(row0 + tk) * NIN + ZC_V + kvh * 64 + p * 16;
            unpack8(*(const u32x4*)kp, kf, 0); unpack8(*(const u32x4*)(kp + 8), kf, 8); unpack8(*(const u32x4*)vp, vf, 0); unpack8(*(const u32x4*)(vp + 8), vf, 8); }
        if (frompast) { const GAS float* kp = C.cache_k() + (((size_t)b * 128 + (128 + tk)) * 4 + kvh) * 64 + p * 16; const GAS float* vp = C.cache_v() + (((size_t)b * 128 + (128 + tk)) * 4 + kvh) * 64 + p * 16;
#pragma unroll
            for (int j = 0; j < 4; ++j) { const f32x4 kv = *(const GAS f32x4*)(kp + 4 * j), vv = *(const GAS f32x4*)(vp + 4 * j);
#pragma unroll
                for (int e = 0; e < 4; ++e) { kf[4 * j + e] = kv[e]; vf[4 * j + e] = vv[e]; } } }
        float ss = 0.f;
#pragma unroll
        for (int j = 0; j < 16; ++j) ss += kf[j] * kf[j];
        ss += __shfl_xor(ss, 1); ss += __shfl_xor(ss, 2);
        if (fromz) { const float rs = rsqrtf(ss * (1.0f / 64.0f) + RMS_EPS);
#pragma unroll
            for (int j = 0; j < 16; ++j) kf[j] = kf[j] * rs * C.kn()[p * 16 + j];
            if (p == 0) { const float* rp = C.rope() + (size_t)(pidx0 + tk) * 16;
#pragma unroll
                for (int i = 0; i < 8; ++i) { const float cs = rp[i], sn = rp[8 + i], x1 = kf[i], x2 = kf[8 + i]; kf[i] = x1 * cs - x2 * sn; kf[8 + i] = x2 * cs + x1 * sn; } } }
        { u32x4 w0, w1; w0.x = cvt_pk_bf16(kf[0], kf[1]); w0.y = cvt_pk_bf16(kf[2], kf[3]); w0.z = cvt_pk_bf16(kf[4], kf[5]); w0.w = cvt_pk_bf16(kf[6], kf[7]);
          w1.x = cvt_pk_bf16(kf[8], kf[9]); w1.y = cvt_pk_bf16(kf[10], kf[11]); w1.z = cvt_pk_bf16(kf[12], kf[13]); w1.w = cvt_pk_bf16(kf[14], kf[15]);
          *(LAS u32x4*)(lds + s * (KS_STRIDE * 2) + p * 32) = w0; *(LAS u32x4*)(lds + s * (KS_STRIDE * 2) + p * 32 + 16) = w1; }
#pragma unroll
        for (int j = 0; j < 16; ++j) *(LAS bf16_t*)(lds + VT_OFF + (p * 16 + j) * (VT_STRIDE * 2) + s * 2) = f2bf(vf[j]);
        if (lastblk && s >= nq && s < nspan) { const int w = s - nq; float* ko = C.o_k(has_past) + (((size_t)b * 128 + w) * 4 + kvh) * 64 + p * 16; float* vo = C.o_v(has_past) + (((size_t)b * 128 + w) * 4 + kvh) * 64 + p * 16;
#pragma unroll
            for (int j = 0; j < 4; ++j) { *(f32x4*)(ko + 4 * j) = (f32x4){kf[4 * j], kf[4 * j + 1], kf[4 * j + 2], kf[4 * j + 3]}; *(f32x4*)(vo + 4 * j) = (f32x4){vf[4 * j], vf[4 * j + 1], vf[4 * j + 2], vf[4 * j + 3]}; } }
    }
    __syncthreads();
    if (nq == 128) attn_compute<true>(C, lds, Z, row0, q0, nq, nspan, pidx0, has_past, kvh, wid, lane);
    else attn_compute<false>(C, lds, Z, row0, q0, nq, nspan, pidx0, has_past, kvh, wid, lane);
    __syncthreads();
}

constexpr int LRU_WREG = 14976, LRU_WOFF = 8 * LRU_WREG, LRU_W1D = (RING_BYTES + 2048) - LRU_WOFF;
static_assert(LRU_WOFF + 9216 <= RING_BYTES && RING_BYTES + 2048 + 9216 <= LDS_BYTES, "LRU LDS map");
template <bool WLDS>
__device__ __forceinline__ void lru_local(const Ctx& C, LAS unsigned char* wl, const LAS unsigned char* wlds, int b, int row0, int T, int has_past, int h, int t0, int ntok, int lane, unsigned (&ub)[64], float& Aout, float& Hout) {
    const int ch = 64 * h + lane, fr = lane & 15, fq = lane >> 4;
    LAS bf16_t* xs = (LAS bf16_t*)wl;
    LAS bf16_t* xcb = (LAS bf16_t*)(wl + 2432);
    LAS float* gr = (LAS float*)(wl + 4736);
    LAS float* gi = (LAS float*)(wl + 4736 + 4096);
    LAS bf16_t* gs = (LAS bf16_t*)(wl + 12928);
    const float cw0 = C.conv_w()[ch], cw1 = C.conv_w()[1024 + ch], cw2 = C.conv_w()[2048 + ch], cw3 = C.conv_w()[3072 + ch], cb = C.conv_b()[ch];
    constexpr float LOG2E_F = 1.4426950408889634f;
    const float nba = -LOG2E_F * C.ba()[ch], nbx = -LOG2E_F * C.bx()[ch];
    float cs; { const float xl = -C.lam()[ch]; cs = (-8.0f * LOG2E_F) * (fmaxf(xl, 0.f) + log1pf(__expf(-fabsf(xl)))); }
    const bf16_t* wap = C.WaT() + h * 4096 + fr * 64 + 8 * fq; const bf16_t* wxp = C.WxT() + h * 4096 + fr * 64 + 8 * fq;
    float hloc = 0.f, aprod = 1.f;
    u32x4 nv[3], ng[2];
#define LRU_XLOAD(TBASE) do { _Pragma("unroll") for (int j = 0; j < 2; ++j) { const int idx = lane + 64 * j, r = idx >> 3, c8 = idx & 7, tt = (TBASE) + r; \
        unsigned zz = 0u; asm volatile("" : "+v"(zz)); u32x4 v; v.x = zz; v.y = zz; v.z = zz; v.w = zz; \
        if (tt < T) v = *(const u32x4*)(C.Z() + (size_t)(row0 + tt) * NIN + ZC_GL + 64 * h + 8 * c8); \
        ng[j] = v; } \
    _Pragma("unroll") for (int j = 0; j < 3; ++j) { const int idx = lane + 64 * j, r = idx >> 3, c8 = idx & 7, tt = (TBASE) - 3 + r; \
        if (idx < 152) { unsigned zz = 0u; asm volatile("" : "+v"(zz)); u32x4 v; v.x = zz; v.y = zz; v.z = zz; v.w = zz; \
            if (tt >= 0 && tt < T) v = *(const u32x4*)(C.Z() + (size_t)(row0 + tt) * NIN + ZC_XL + 64 * h + 8 * c8); \
            else if (tt < 0 && has_past) { const GAS float* pp = C.state_conv() + ((size_t)b * 3 + (3 + tt)) * 1024 + 64 * h + 8 * c8; const f32x4 p0 = *(const GAS f32x4*)pp, p1 = *(const GAS f32x4*)(pp + 4); \
                v.x = cvt_pk_bf16(p0[0], p0[1]); v.y = cvt_pk_bf16(p0[2], p0[3]); v.z = cvt_pk_bf16(p1[0], p1[1]); v.w = cvt_pk_bf16(p1[2], p1[3]); } \
            nv[j] = v; } } } while (0)
    { unsigned zz = 0u; asm volatile("" : "+v"(zz)); nv[0].x = zz; nv[0].y = zz; nv[0].z = zz; nv[0].w = zz; nv[1] = nv[0]; nv[2] = nv[0]; ng[0] = nv[0]; ng[1] = nv[0]; }
    LRU_XLOAD(t0);
#pragma unroll
    for (int tb = 0; tb < 4; ++tb) {
        if (16 * tb < ntok) {
#pragma unroll
            for (int j = 0; j < 3; ++j) { const int idx = lane + 64 * j; if (idx < 152) *(LAS u32x4*)(xs + (idx >> 3) * 64 + 8 * (idx & 7)) = nv[j]; }
#pragma unroll
            for (int j = 0; j < 2; ++j) { const int idx = lane + 64 * j; *(LAS u32x4*)(gs + (idx >> 3) * 64 + 8 * (idx & 7)) = ng[j]; }
            __builtin_amdgcn_sched_barrier(0);
            if (16 * (tb + 1) < ntok) LRU_XLOAD(t0 + 16 * (tb + 1));
            __builtin_amdgcn_sched_barrier(0);
            LDS_WAIT();
            float xr[19], xc[16];
#pragma unroll
            for (int r = 0; r < 19; ++r) xr[r] = bf1(xs[r * 64 + lane]);
#pragma unroll
            for (int k = 0; k < 16; ++k) { xc[k] = __builtin_fmaf(cw3, xr[k + 3], __builtin_fmaf(cw2, xr[k + 2], __builtin_fmaf(cw1, xr[k + 1], __builtin_fmaf(cw0, xr[k], cb)))); xcb[k * 72 + lane] = f2bf(xc[k]); }
            LDS_WAIT();
            { bf16x8 af[2];
#pragma unroll
              for (int ks = 0; ks < 2; ++ks) af[ks] = *(const LAS bf16x8*)(xcb + fr * 72 + 32 * ks + 8 * fq);
#pragma unroll
              for (int db = 0; db < 4; ++db) { f32x4 ar = (f32x4){0.f, 0.f, 0.f, 0.f}, ai = (f32x4){0.f, 0.f, 0.f, 0.f};
#pragma unroll
                  for (int ks = 0; ks < 2; ++ks) { bf16x8 wav, wxv;
                      if (WLDS) { wav = *(const LAS bf16x8*)(wlds + ((16 * db + fr) * 72 + 32 * ks + 8 * fq) * 2); wxv = *(const LAS bf16x8*)(wlds + LRU_W1D + ((16 * db + fr) * 72 + 32 * ks + 8 * fq) * 2); }
                      else { wav = *(const bf16x8*)(wap + db * 1024 + 32 * ks); wxv = *(const bf16x8*)(wxp + db * 1024 + 32 * ks); }
                      ar = __builtin_amdgcn_mfma_f32_16x16x32_bf16(af[ks], wav, ar, 0, 0, 0); ai = __builtin_amdgcn_mfma_f32_16x16x32_bf16(af[ks], wxv, ai, 0, 0, 0); }
#pragma unroll
                  for (int i = 0; i < 4; ++i) { gr[(4 * fq + i) * 64 + 16 * db + fr] = ar[i]; gi[(4 * fq + i) * 64 + 16 * db + fr] = ai[i]; } } }
            LDS_WAIT();
            int gbase = lane;
#pragma unroll
            for (int k = 0; k < 16; ++k) {
                if ((k & 3) == 0) asm volatile("" : "+v"(gbase), "+v"(hloc), "+v"(aprod));
                const float r = __builtin_amdgcn_rcpf(1.0f + __builtin_amdgcn_exp2f(__builtin_fmaf(gr[k * 64 + gbase], -LOG2E_F, nba)));
                const float ig = __builtin_amdgcn_rcpf(1.0f + __builtin_amdgcn_exp2f(__builtin_fmaf(gi[k * 64 + gbase], -LOG2E_F, nbx)));
                const float aa = __builtin_amdgcn_exp2f(r * cs), bb = __builtin_amdgcn_sqrtf(__builtin_fmaf(-aa, aa, 1.0f)) * ig * xc[k];
                const float gl = bf1(gs[k * 64 + gbase]);
                const float eg = __builtin_amdgcn_exp2f(gl * __builtin_fmaf(gl * gl, 0.10294324f, 2.3022082f));
                float G = __builtin_fmaf(-gl, __builtin_amdgcn_rcpf(1.0f + eg), gl);
                const bool live = 16 * tb + k < ntok;
                float av = live ? aa : 1.0f, bm = live ? bb : 0.f;
                asm("" : "+v"(G)); asm("" : "+v"(av)); asm("" : "+v"(bm));
                hloc = av * hloc + bm; aprod *= av;
                float pg = aprod * G, hg = hloc * G; asm("" : "+v"(pg)); asm("" : "+v"(hg));
                unsigned pk = cvt_pk_bf16(pg, hg); ub[16 * tb + k] = live ? pk : 0u;
                }
            LDS_WAIT();
        } else {
#pragma unroll
            for (int k = 0; k < 16; ++k) ub[16 * tb + k] = 0u;
        }
    }
#undef LRU_XLOAD
    Aout = aprod; Hout = hloc;
}
__device__ __forceinline__ void lru_final(const Ctx& C, int row0, int h, int t0, int ntok, int lane, const unsigned (&ub)[64], float carry) {
    const int ch = 64 * h + lane;
    bf16_t* yo = C.BR() + (size_t)(row0 + t0) * NBR + BRC_LRU + ch;
#pragma unroll
    for (int k = 0; k < 64; ++k) { if (k < ntok) yo[(size_t)k * NBR] = f2bf(bf_hi(ub[k]) + bf_lo(ub[k]) * carry); }
}
__device__ __forceinline__ void lru_states(const Ctx& C, int has_past, int b, int row0, int T, int h, int lane, float hend) {
    const int ch = 64 * h + lane;
    C.o_h(has_past)[b * 1024 + ch] = hend;
#pragma unroll
    for (int j = 0; j < 3; ++j) C.o_conv(has_past)[((size_t)b * 3 + j) * 1024 + ch] = bf1(C.Z()[(size_t)(row0 + T - 3 + j) * NIN + ZC_XL + ch]);
}
#define RLX_AGENT __ATOMIC_RELAXED, __HIP_MEMORY_SCOPE_AGENT
__device__ __forceinline__ void lru_prompt_item(const Ctx& C, LAS unsigned char* lds, int item, int wave, int lane) {
    const int s = item >> 6, seq = (item >> 4) & 3, h = item & 15, row0 = seq * 2048, t0 = 512 * s + 64 * wave;
    unsigned ub[64]; float Ac, Hc;
    { const int t = wave * 64 + lane, mat = t >> 8, r = (t >> 2) & 63, ch4 = t & 3; const bf16_t* src = (mat ? C.WxT() : C.WaT()) + h * 4096 + r * 64 + ch4 * 16;
      const u32x4 v0 = *(const u32x4*)src, v1 = *(const u32x4*)(src + 8); LAS unsigned char* dst = lds + LRU_WOFF + mat * LRU_W1D + r * 144 + ch4 * 32;
      *(LAS u32x4*)dst = v0; *(LAS u32x4*)(dst + 16) = v1; }
    __syncthreads();
    lru_local<true>(C, lds + wave * LRU_WREG, lds + LRU_WOFF, seq, row0, 2048, 0, h, t0, 64, lane, ub, Ac, Hc);
    asm volatile("" : "+v"(Ac)); asm volatile("" : "+v"(Hc));
    __syncthreads();
    LAS float* xA = (LAS float*)lds; LAS float* xH = xA + 512;
    xA[wave * 64 + lane] = Ac; xH[wave * 64 + lane] = Hc;
    __syncthreads();
    float Apre = 1.f, Hpre = 0.f, Atot = 1.f, Htot = 0.f;
#pragma unroll
    for (int w = 0; w < 8; ++w) { float va = xA[w * 64 + lane], vh = xH[w * 64 + lane]; asm volatile("" : "+v"(va)); asm volatile("" : "+v"(vh));
        if (w < wave) { Hpre = va * Hpre + vh; Apre *= va; } Htot = va * Htot + vh; Atot *= va; }
    typedef GAS unsigned long long gu64;
    gu64* gbase = (gu64*)(C.ws + WS_LRUG); const unsigned tag = (unsigned)C.l + 1u;
    if (wave == 0) { gu64* gp = gbase + (size_t)item * 128 + 2 * lane;
        __hip_atomic_store(gp, ((unsigned long long)tag << 32) | __float_as_uint(Atot), RLX_AGENT); __hip_atomic_store(gp + 1, ((unsigned long long)tag << 32) | __float_as_uint(Htot), RLX_AGENT); }
    float hin = 0.f;
    for (int sp = 0; sp < s; ++sp) { gu64* gp = gbase + (size_t)(sp * 64 + seq * 16 + h) * 128 + 2 * lane; unsigned long long x0 = 0, x1 = 0;
        for (unsigned spins = 0; spins < (1u << 16); ++spins) { x0 = __hip_atomic_load(gp, RLX_AGENT); x1 = __hip_atomic_load(gp + 1, RLX_AGENT);
            if (__all((unsigned)(x0 >> 32) == tag && (unsigned)(x1 >> 32) == tag)) break; __builtin_amdgcn_s_sleep(2); }
        hin = __uint_as_float((unsigned)x0) * hin + __uint_as_float((unsigned)x1); }
    const float carry = Apre * hin + Hpre;
    lru_final(C, row0, h, t0, 64, lane, ub, carry);
    if (s == 3 && wave == 7) lru_states(C, 0, seq, row0, 2048, h, lane, Ac * carry + Hc);
    __syncthreads();
}
__device__ __forceinline__ void lru_sample_item(const Ctx& C, LAS unsigned char* wl, int item, int lane) {
    const int b = item >> 4, h = item & 15, row0 = MP + 8 * b;
    unsigned ub[64]; float Ac, Hc;
    lru_local<false>(C, wl, nullptr, b, row0, 8, 1, h, 0, 8, lane, ub, Ac, Hc);
    const float carry = C.state_h()[b * 1024 + 64 * h + lane];
    lru_final(C, row0, h, 0, 8, lane, ub, carry);
    lru_states(C, 1, b, row0, 8, h, lane, Ac * carry + Hc);
}

__device__ __forceinline__ void pool_group(const Ctx& C, int grp, int lane) {
    const int rowA = 4 * grp; int b, tA, has_past, posA, row0;
    if (rowA < MP) { b = rowA >> 11; tA = rowA & 2047; has_past = 0; posA = tA; row0 = b * 2048; } else { b = (rowA - MP) >> 3; tA = (rowA - MP) & 7; has_past = 1; posA = 16384 + tA; row0 = MP + 8 * b; }
#pragma unroll
    for (int step = 0; step < 2; ++step) { const int cidx = lane + 64 * step, g = cidx >> 5, w = 2 << g;
        float S[4][8], U[4][8];
#pragma unroll
        for (int r = 0; r < 4; ++r)
#pragma unroll
            for (int e = 0; e < 8; ++e) { S[r][e] = 0.f; U[r][e] = 0.f; }
#pragma unroll
        for (int d = 0; d < 19; ++d) { const int tt = tA + 3 - d; float v[8];
#pragma unroll
            for (int e = 0; e < 8; ++e) v[e] = 0.f;
            if (d < w + 3) {
                if (tt >= 0) { const u32x4 q = *(const u32x4*)(C.Z() + (size_t)(row0 + tt) * NIN + 8 * cidx); v[0] = bf_lo(q.x); v[1] = bf_hi(q.x); v[2] = bf_lo(q.y); v[3] = bf_hi(q.y); v[4] = bf_lo(q.z); v[5] = bf_hi(q.z); v[6] = bf_lo(q.w); v[7] = bf_hi(q.w); }
                else if (has_past) { const GAS float* pp = C.state_pool() + ((size_t)b * 15 + (15 + tt)) * 1024 + 8 * cidx; const f32x4 p0 = *(const GAS f32x4*)pp, p1 = *(const GAS f32x4*)(pp + 4);
                    v[0] = p0[0]; v[1] = p0[1]; v[2] = p0[2]; v[3] = p0[3]; v[4] = p1[0]; v[5] = p1[1]; v[6] = p1[2]; v[7] = p1[3]; } }
#pragma unroll
            for (int r = 0; r < 4; ++r) { if (d >= r) { const bool in = (d < r + w);
#pragma unroll
                for (int e = 0; e < 8; ++e) { S[r][e] += in ? v[e] : 0.f; if (d == r) U[r][e] = v[e]; } } } }
#pragma unroll
        for (int r = 0; r < 4; ++r) { const int pos = posA + 3 - r; const int cnt = (pos + 1) < w ? (pos + 1) : w; const float ic = 1.0f / (float)cnt; float dd[8];
#pragma unroll
            for (int e = 0; e < 8; ++e) dd[e] = S[r][e] * ic - U[r][e];
            u32x4 o; o.x = cvt_pk_bf16(dd[0], dd[1]); o.y = cvt_pk_bf16(dd[2], dd[3]); o.z = cvt_pk_bf16(dd[4], dd[5]); o.w = cvt_pk_bf16(dd[6], dd[7]);
            *(u32x4*)(C.BR() + (size_t)(rowA + 3 - r) * NBR + BRC_POOL + 8 * cidx) = o; } }
}
__device__ __forceinline__ void newpool_item(const Ctx& C, int item, int lane) {
    const int seq = item / 15, j = item - seq * 15; int b, T, row0, has_past;
    if (seq < 4) { b = seq; T = 2048; row0 = seq * 2048; has_past = 0; } else { b = seq - 4; T = 8; row0 = MP + 8 * b; has_past = 1; }
    const int fi = T + j; float* o = C.o_pool(has_past) + ((size_t)b * 15 + j) * 1024;
#pragma unroll
    for (int k = 0; k < 4; ++k) { const int c = 4 * lane + 256 * k; f32x4 v = (f32x4){0.f, 0.f, 0.f, 0.f};
        if (fi >= 15) { const u32x2 q = *(const u32x2*)(C.Z() + (size_t)(row0 + fi - 15) * NIN + c); v[0] = bf_lo(q.x); v[1] = bf_hi(q.x); v[2] = bf_lo(q.y); v[3] = bf_hi(q.y); }
        else if (has_past) v = *(const GAS f32x4*)(C.state_pool() + ((size_t)b * 15 + fi) * 1024 + c);
        *(f32x4*)(o + c) = v; }
}

__global__ void __launch_bounds__(512, 2) fwd(Args args) {
    extern __shared__ __attribute__((aligned(16))) unsigned char lds_raw[];
    LAS unsigned char* lds = (LAS unsigned char*)lds_raw;
    const int tid = threadIdx.x, lane = tid & 63, wave = __builtin_amdgcn_readfirstlane(tid >> 6);
    const int G = gridDim.x, bx = blockIdx.x, vcu = (G % 8 == 0) ? (bx % 8) * (G / 8) + bx / 8 : bx;
    const int gw = vcu * 8 + wave, NGW = G * 8;
    unsigned char* ws = args.ws;
    unsigned* ctl = (unsigned*)(ws + WS_CTL);
    for (int u = tid; u < (LDS_BYTES - LDSCTL_OFF) / 4; u += 512) ((LAS unsigned*)(lds + LDSCTL_OFF))[u] = 0u;
    __syncthreads();
    XcdBarrier bar; bar.bar = ctl + CW_BAR; bar.x = 0; bar.st = nullptr;
    if (!MK_PER_PHASE) bar = xcd_barrier_post(ctl + CW_BAR, (volatile LAS unsigned*)(lds + MISC_OFF) + 8);
    const int lo = args.ph_lo, hi = args.ph_hi;
    int pid = 0;
#define IN(k) (lo <= (k) && (k) < hi)
#ifndef SEAM_REPS
#define SEAM_REPS 1
#endif
#ifndef DNX
#define DNX 8
#endif
#ifndef SLOT_GU
#define SLOT_GU 40
#endif
#ifndef SLOT_IN
#define SLOT_IN 40
#endif
    unsigned* sptr = ctl + CW_SPTR; volatile LAS unsigned* bar_st = (volatile LAS unsigned*)(lds + MISC_OFF) + 8;
#define SEAM(PSV, NEED) do { if (IN(pid)) { int stid = threadIdx.x; asm volatile("" : "+v"(stid)); const int swv = __builtin_amdgcn_readfirstlane(stid >> 6); \
            (void)swv; if ((NEED) > 0) convert_wg(PSV, ws, lds, bar_st, sptr, (NEED), 0); \
            if (!MK_PER_PHASE && IN(pid + 1)) { xcd_barrier(bar); } } ++pid; } while (0)
    const PSTbl PT{(const float* const*)(ws + WS_TBL)}; const PSArgs PA{&args};
    float* X = args.out;
    bf16_t* XB = (bf16_t*)(ws + WS_XB); bf16_t* ACT = (bf16_t*)(ws + WS_ACT); bf16_t* Zb = (bf16_t*)(ws + WS_Z); bf16_t* BR = (bf16_t*)(ws + WS_BR);
    bf16_t* MB = (bf16_t*)(ws + WS_MB);
    u64* SS = (u64*)(ws + WS_CTL + (size_t)CW_SS * 4);

    if (EN(0) && IN(pid)) { for (int rep = 0; rep < REPS(0); ++rep) prologue(args, lds, gw, NGW, wave, lane); }
    SEAM(PA, tt_need(0, 0));
#pragma unroll 1
    for (int s = 0; s < 8; ++s) {
        const int l = s >> 1, which = s & 1;
        unsigned char* lw = ws + WS_W + (size_t)l * LW_STRIDE;
        if (EN(2) && IN(pid)) {
            pg8::Gemm g{XB, (const bf16_t*)(lw + (which ? LW_GUB : LW_GUA)), D, D, D};
            pg8::OrderStd S; S.init(M / 256, NGU / 256, 1, G, bx, D, D, 0, 0);
            pg8::EpiGU E{ACT, SS + (size_t)(3 * l + 2 * which) * M};
            for (int rep = 0; rep < REPS(2); ++rep) pg8::gemm_phase<false>(lds, g, S, E);
            if (s == 0) {
                const int nwg_ = (M / 256) * (NGU / 256), nmax_ = (nwg_ + G - 1) / G, nfull_ = nwg_ - (nmax_ - 1) * G, nidle_ = G - nfull_;
                if (nidle_ == 0 || bx >= nfull_) {
                    pg8::Gemm gw_{(const bf16_t*)(ws + WS_WBPT), (const bf16_t*)(ws + WS_PP), 1024, 256, 256};
                    pg8::OrderWeff Sw{nidle_ == 0 ? G : nidle_, nidle_ == 0 ? bx : bx - nfull_}; pg8::EpiWeff Ew{(bf16_t*)(ws + WS_W + LW_CAT)};
                    pg8::gemm_phase<false>(lds, gw_, Sw, Ew); }
            }
            {
                const int nwg_ = (M / 256) * (NGU / 256), nmax_ = (nwg_ + G - 1) / G, nfull_ = nwg_ - (nmax_ - 1) * G, nidle_ = G - nfull_;
                if (nidle_ == 0 || bx >= nfull_) { int ptid = threadIdx.x; asm volatile("" : "+v"(ptid)); const int plane = ptid & 63, pwave = __builtin_amdgcn_readfirstlane(ptid >> 6);
                    const PSTbl P{(const float* const*)(ws + WS_TBL)};
                    convert_wg(P, ws, lds, bar_st, sptr, TT_TOTAL, s == 0 ? SLOT_GU - 16 : SLOT_GU);     (void)plane; (void)pwave; }
            }
        }
        SEAM(PT, tt_need(l, which ? 7 : 1));
        if (EN(3) && IN(pid)) {
            pg8::Gemm g{ACT, (const bf16_t*)(lw + (which ? LW_DNB : LW_DNA)), FF, FF, FF};
            pg8::OrderRide S; S.init(G, bx, FF, FF);
            pg8::EpiRes E{(s == 7) ? X : nullptr, XB, SS + (size_t)(3 * l + 2 * which + 1) * M, 0.5f};
            pg8::gemm_phase<true>(lds, g, S, E);
            { pg8::Unit u0; if (DNX > 0 && S.next(0, u0) && u0.xrow < 0) convert_wg(PT, ws, lds, bar_st, sptr, TT_TOTAL, DNX); }
            if (REPS(3) > 1) { __syncthreads(); pg8::EpiRes E2{nullptr, XB, (u64*)(ws + WS_MRG), 0.0f}; pg8::gemm_phase<true>(lds, g, S, E2); }
        }
        SEAM(PT, (which == 0) ? tt_need(l, 2) : (l + 1 < DEPTH ? tt_need(l + 1, 0) : 0));
        if (which == 0) {
            if (EN(4) && IN(pid)) {
                pg8::Gemm g{XB, (const bf16_t*)(lw + LW_IN), D, D, D};
                pg8::OrderStd S; S.init(M / 256, NIN / 256, 1, G, bx, D, D, 0, 0);
                pg8::EpiIn E{Zb, SS + (size_t)(3 * l + 1) * M};
                for (int rep = 0; rep < REPS(4); ++rep) pg8::gemm_phase<false>(lds, g, S, E);
            {
                    const int nwg_ = (M / 256) * (NIN / 256), nmax_ = (nwg_ + G - 1) / G, nfull_ = nwg_ - (nmax_ - 1) * G, nidle_ = G - nfull_;
                    if (nidle_ == 0 || bx >= nfull_) { int ptid = threadIdx.x; asm volatile("" : "+v"(ptid)); const int plane = ptid & 63, pwave = __builtin_amdgcn_readfirstlane(ptid >> 6);
                        const PSTbl P{(const float* const*)(ws + WS_TBL)};
                        convert_wg(P, ws, lds, bar_st, sptr, TT_TOTAL, SLOT_IN); (void)plane; (void)pwave; }
                }
            }
            SEAM(PT, tt_need(l, 3));
            Ctx C; C.tbl = (const float* const*)(ws + WS_TBL); C.ws = ws; C.out = X; C.l = l;
            if (IN(pid)) {
                _Pragma("unroll 1") for (int rep = 0; rep < REPS(5); ++rep) {
                int ptid = threadIdx.x; asm volatile("" : "+v"(ptid)); const int plane = ptid & 63, pwave = __builtin_amdgcn_readfirstlane(ptid >> 6), pgw = vcu * 8 + pwave;
                _Pragma("unroll 1") for (int r2 = 0; r2 < REPS(11); ++r2) { if (EN(6)) for (int it = bx; it < 256; it += G) lru_prompt_item(C, lds, it, pwave, plane); }
                _Pragma("unroll 1") for (int r2 = 0; r2 < REPS(12); ++r2) { if (EN(5)) for (int a = bx; a < N_ATT_UNITS; a += G) attn_unit(C, lds, a, ptid, pwave, plane); }
                __syncthreads();
                if (EN(6)) for (int it = NGW - 1 - (bx * 8 + pwave); it < 512; it += NGW) lru_sample_item(C, lds + pwave * 16384, it, plane);
                { const int wlo = bx * 8 + pwave, half = (G / 2) * 8, nhi = NGW - half, NG4 = M / 4; const int share_hi = nhi > 0 ? (NG4 * 5) / 6 : 0;
                  if (EN(7)) { if (wlo >= half) { for (int g4 = wlo - half; g4 < share_hi; g4 += nhi) pool_group(C, g4, plane); for (int it = wlo - half; it < NSEQ * 15; it += nhi) newpool_item(C, it, plane); }
                               else { for (int g4 = share_hi + wlo; g4 < NG4; g4 += half) pool_group(C, g4, plane); }
                               if (nhi <= 0) for (int it = wlo; it < NSEQ * 15; it += NGW) newpool_item(C, it, plane); } }
                __syncthreads(); }
            }
            SEAM(PT, tt_need(l, 4));
            if (EN(9) && IN(pid)) {
                pg8::Gemm g{BR, (const bf16_t*)(lw + LW_CAT), NBR, NBR, NBR};
                pg8::OrderRide S; S.init(G, bx, NBR, NBR);
                pg8::EpiBr E{Zb, MB};
                for (int rep = 0; rep < REPS(9); ++rep) pg8::gemm_phase<true>(lds, g, S, E);
            }
            SEAM(PT, tt_need(l, 5));
            if (EN(10) && IN(pid)) {
                pg8::Gemm g{MB, (const bf16_t*)(lw + LW_OUT), D, D, D};
                pg8::OrderRide S; S.init(G, bx, D, D);
                pg8::EpiRes E{nullptr, XB, SS + (size_t)(3 * l + 2) * M, 1.0f};
                pg8::gemm_phase<true>(lds, g, S, E);
                if (REPS(10) > 1) { __syncthreads(); pg8::EpiRes E2{nullptr, XB, (u64*)(ws + WS_MRG), 0.0f}; pg8::gemm_phase<true>(lds, g, S, E2); }
            }
            SEAM(PT, tt_need(l, 6));
        }
    }
#undef IN
#undef SEAM
}
constexpr int N_PHASES = 1 + 4 * 8;

extern "C" void kernel_launch(void* const* d_in, const int* in_sizes, int n_in, void* d_out, int out_size, void* d_ws, size_t ws_size, hipStream_t stream) {
    static int grid = 0;
    if (grid == 0) {
        if (n_in != 31 || (size_t)out_size != O_END || ws_size < WS_END) { fprintf(stderr, "kernel_launch: unexpected shapes: n_in %d out %d (want %zu) ws %zu (want >= %zu)\n", n_in, out_size, (size_t)O_END, ws_size, (size_t)WS_END); grid = -1; return; }
        int dev = 0, cus = 0, per_cu = 0;
        if (hipGetDevice(&dev) != hipSuccess || hipDeviceGetAttribute(&cus, hipDeviceAttributeMultiprocessorCount, dev) != hipSuccess) { grid = -1; return; }
        if (hipFuncSetAttribute((const void*)fwd, hipFuncAttributeMaxDynamicSharedMemorySize, LDS_BYTES) != hipSuccess) { fprintf(stderr, "kernel_launch: hipFuncSetAttribute failed\n"); grid = -1; return; }
        if (hipOccupancyMaxActiveBlocksPerMultiprocessor(&per_cu, (const void*)fwd, 512, LDS_BYTES) != hipSuccess || per_cu < 1) fprintf(stderr, "kernel_launch: occupancy query says %d\n", per_cu);
        (void)hipGetLastError();
        grid = cus;
    }
    if (grid < 0) return;
    if (hipMemsetAsync((char*)d_ws + WS_CTL, 0, CTL_BYTES, stream) != hipSuccess) return;
    Args a{};
    for (int i = 0; i < 31; ++i) a.in[i] = (const float*)d_in[i];
    a.out = (float*)d_out; a.ws = (unsigned char*)d_ws;
#if MK_PER_PHASE
    for (int p = 0; p < N_PHASES; ++p) { a.ph_lo = p; a.ph_hi = p + 1; hipLaunchKernelGGL(fwd, dim3(grid), dim3(512), LDS_BYTES, stream, a); }
#else
    a.ph_lo = 0; a.ph_hi = N_PHASES;
    hipLaunchKernelGGL(fwd, dim3(grid), dim3(512), LDS_BYTES, stream, a);
#endif
}
```

```cpp
#include <hip/hip_runtime.h>
#include <cstdio>
#include <cstdint>

#ifndef MK_PER_PHASE
#define MK_PER_PHASE 0
#endif
#ifndef EN_MASK
#define EN_MASK 0xFFFF
#endif
#define EN(b) ((EN_MASK >> (b)) & 1)
#ifndef REP_MASK
#define REP_MASK 0
#endif
#define REPS(b) (1 + ((REP_MASK >> (b)) & 1))

#define LAS __attribute__((address_space(3)))
#define GAS __attribute__((address_space(1)))
typedef unsigned short bf16_t;
typedef short bf16x8 __attribute__((ext_vector_type(8)));
typedef float f32x4 __attribute__((ext_vector_type(4)));
typedef float f32x2 __attribute__((ext_vector_type(2)));
typedef unsigned u32x4 __attribute__((ext_vector_type(4)));
typedef unsigned u32x2 __attribute__((ext_vector_type(2)));

constexpr int D = 2048, MP = 8192, MS = 256, M = MP + MS, DEPTH = 4;
constexpr int FF = 5632, NGU = 2 * FF, NIN = 10752, NBR = 3072;
constexpr int ZC_Q = 1024, ZC_K = 2048, ZC_V = 2304, ZC_XL = 2560, ZC_GL = 3584, ZC_G = 4608;
constexpr int BRC_POOL = 0, BRC_ATT = 1024, BRC_LRU = 2048;
constexpr float RMS_EPS = 1e-6f;
constexpr int NSEQ = 36, NCHUNK = 32;
constexpr int N_ATT_UNITS = 256 + 128;
constexpr int N_LRU_ITEMS = 2048 + 512;

constexpr size_t O_Y = 0;
constexpr size_t O_POOL_P = (size_t)M * D;
constexpr size_t O_POOL_S = O_POOL_P + (size_t)4 * 4 * 15 * 1024;
constexpr size_t O_K_P = O_POOL_S + (size_t)4 * 32 * 15 * 1024;
constexpr size_t O_K_S = O_K_P + (size_t)4 * 4 * 128 * 256;
constexpr size_t O_V_P = O_K_S + (size_t)4 * 32 * 128 * 256;
constexpr size_t O_V_S = O_V_P + (size_t)4 * 4 * 128 * 256;
constexpr size_t O_CONV_P = O_V_S + (size_t)4 * 32 * 128 * 256;
constexpr size_t O_CONV_S = O_CONV_P + (size_t)4 * 4 * 3 * 1024;
constexpr size_t O_H_P = O_CONV_S + (size_t)4 * 32 * 3 * 1024;
constexpr size_t O_H_S = O_H_P + (size_t)4 * 4 * 1024;
constexpr size_t O_END = O_H_S + (size_t)4 * 32 * 1024;

constexpr size_t MiB = 1u << 20;
constexpr size_t WS_CTL = 0, CTL_BYTES = 2 * MiB;
constexpr int CW_TMO = 0, CW_BAR = 4096, CW_SS = 16384;
constexpr size_t WS_LRUG = 1 * MiB;
constexpr size_t WS_ROPE = 2 * MiB;
constexpr size_t WS_TBL = 2 * MiB + 512 * 1024;
constexpr size_t WS_SUMM = 3 * MiB;
constexpr size_t WS_PP = 4 * MiB;
constexpr size_t WS_GATE = 6 * MiB;
constexpr size_t WS_WBPT = 8 * MiB;
constexpr size_t WS_W = 24 * MiB;
constexpr size_t LW_GUA = 0, LW_DNA = 44 * MiB, LW_IN = 66 * MiB, LW_CAT = 108 * MiB, LW_OUT = 120 * MiB, LW_GUB = 128 * MiB, LW_DNB = 172 * MiB, LW_STRIDE = 194 * MiB;
constexpr size_t WS_XB = WS_W + 4 * LW_STRIDE;
constexpr size_t WS_ACT = WS_XB + 33 * MiB;
constexpr size_t WS_Z = WS_ACT + 91 * MiB;
constexpr size_t WS_BR = WS_Z + 174 * MiB;
constexpr size_t WS_MRG = WS_BR + 50 * MiB;
constexpr size_t WS_MB = WS_MRG + 66 * MiB;
constexpr size_t WS_END = WS_MB + 33 * MiB;
static_assert((size_t)CW_SS * 4 + (size_t)13 * M * 8 <= CTL_BYTES, "ctl");
static_assert((size_t)M * D * 2 <= 33 * MiB && (size_t)M * FF * 2 <= 91 * MiB && (size_t)M * NIN * 2 <= 174 * MiB && (size_t)M * NBR * 2 <= 50 * MiB && (size_t)M * D * 4 <= 66 * MiB, "ws");
static_assert((size_t)NGU * D * 2 <= 44 * MiB && (size_t)D * FF * 2 <= 22 * MiB && (size_t)NIN * D * 2 <= 42 * MiB && (size_t)D * NBR * 2 <= 12 * MiB && (size_t)D * D * 2 <= 8 * MiB, "ws w");

constexpr int RING_BYTES = 131072;
constexpr int LDSCTL_OFF = RING_BYTES, MISC_OFF = LDSCTL_OFF + 320;
constexpr int LDS_BYTES = 147456;

typedef __bf16 bf16x2_t __attribute__((ext_vector_type(2)));
__device__ __forceinline__ unsigned cvt_pk_bf16(float lo, float hi) { const f32x2 v = {lo, hi}; return __builtin_bit_cast(unsigned, __builtin_convertvector(v, bf16x2_t)); }
__device__ __forceinline__ float bf_lo(unsigned w) { return __uint_as_float(w << 16); }
__device__ __forceinline__ float bf_hi(unsigned w) { return __uint_as_float(w & 0xffff0000u); }
__device__ __forceinline__ float bf1(bf16_t b) { return __uint_as_float(((unsigned)b) << 16); }
__device__ __forceinline__ bf16_t f2bf(float f) { return (bf16_t)(cvt_pk_bf16(f, 0.f) & 0xffffu); }
__device__ __forceinline__ float sigmoidf_(float x) { return __builtin_amdgcn_rcpf(1.0f + __expf(-x)); }
typedef unsigned u32x2v __attribute__((ext_vector_type(2)));
__device__ __forceinline__ float xsum_16_32(float x) {
    u32x2v r = __builtin_amdgcn_permlane16_swap(__float_as_uint(x), __float_as_uint(x), false, false); const float y = __uint_as_float(r[0]) + __uint_as_float(r[1]);
    u32x2v q = __builtin_amdgcn_permlane32_swap(__float_as_uint(y), __float_as_uint(y), false, false); return __uint_as_float(q[0]) + __uint_as_float(q[1]); }
__device__ __forceinline__ float xmax_16_32(float x) {
    u32x2v r = __builtin_amdgcn_permlane16_swap(__float_as_uint(x), __float_as_uint(x), false, false); const float y = fmaxf(__uint_as_float(r[0]), __uint_as_float(r[1]));
    u32x2v q = __builtin_amdgcn_permlane32_swap(__float_as_uint(y), __float_as_uint(y), false, false); return fmaxf(__uint_as_float(q[0]), __uint_as_float(q[1])); }
__device__ __forceinline__ float expm1_neg(float x) { const float p = x * (1.0f + x * (0.5f + x * (0.16666667f + x * (0.041666668f + x * (0.0083333338f + x * 0.0013888889f))))); return x > -0.35f ? p : __expf(x) - 1.0f; }
typedef unsigned long long u64;
__device__ __forceinline__ u64 ss_fix(float s) { return (u64)((double)s * 68719476736.0 + 0.5); }
__device__ __forceinline__ float rstd_of(unsigned hi) { return rsqrtf((float)hi * (1.0f / 16.0f / 2048.0f) + RMS_EPS); }
#define LDS_WAIT() asm volatile("s_waitcnt lgkmcnt(0)" ::: "memory")
#define VM_WAIT() asm volatile("s_waitcnt vmcnt(0)" ::: "memory")

namespace pg8 {
constexpr int BM = 256, BK = 64, HALF = 128, HTB = HALF * BK * 2, STAGE_BYTES = 8 * HTB, NXCD = 8, WGM = 8;
__device__ __forceinline__ int lds_byte(int r, int c) { const int st = (r >> 4) * 2 + (c >> 5), rr = r & 15, cc = c & 31, ob = rr * 64 + cc * 2; return st * 1024 + (ob ^ (((ob >> 9) & 1) << 5)); }
__device__ __forceinline__ void stage_rc(int b, int& R, int& C) { const int st = b / 1024, sb = b % 1024, swz = sb ^ (((sb >> 9) & 1) << 5); R = (st >> 1) * 16 + swz / 64; C = (st & 1) * 32 + (swz % 64) / 2; }
__device__ __forceinline__ int perm32(int rho) { const int n = rho >> 4, i = rho & 15; return 8 * (i >> 2) + 4 * n + (i & 3); }

struct Unit { int pm, pn, pz, xrow; long aoff, boff, xoff; };
struct Gemm { const bf16_t* A; const bf16_t* Bt; int lda, ldb, K; };

struct OrderStd {
    int nM, nN, nZ, nwg, G, c; long aM, aZ, bN, bZ;
    __device__ __forceinline__ void init(int nM_, int nN_, int nZ_, int G_, int c_, long lda, long ldb, long aZ_, long bZ_) {
        nM = nM_; nN = nN_; nZ = nZ_; nwg = nM * nN; G = G_; c = c_; aM = 256 * lda; bN = 256 * ldb; aZ = aZ_; bZ = bZ_; }
    __device__ __forceinline__ bool next(int i, Unit& u) const {
        const int j = i / nZ, z = i - j * nZ;
        const long L = (long)j * G + c; if (L >= nwg) return false;
        int wgid = (int)L; { const int q = nwg / NXCD, r = nwg % NXCD, xcd = wgid % NXCD, off = wgid / NXCD; wgid = (xcd < r ? xcd * (q + 1) : r * (q + 1) + (xcd - r) * q) + off; }
        const int nig = WGM * nN, gid = wgid / nig, fm = gid * WGM, gsz = (nM - fm) < WGM ? (nM - fm) : WGM;
        u.pm = fm + ((wgid % nig) % gsz); u.pn = (wgid % nig) / gsz; u.pz = z;
        u.aoff = (long)u.pm * aM + (long)z * aZ; u.boff = (long)u.pn * bN + (long)z * bZ; u.xrow = -1; u.xoff = u.aoff; return true;
    }
};
struct OrderRide {
    OrderStd o; long lda;
    __device__ __forceinline__ void init(int G_, int c_, long lda_, long ldb) { o.init(MP / 256, D / 256, 1, G_, c_, lda_, ldb, 0, 0); lda = lda_; }
    __device__ __forceinline__ bool next(int i, Unit& u) const { if (!o.next(i, u)) return false; if (u.pm < 16) { u.xrow = MP + 16 * u.pm; u.xoff = (long)u.xrow * lda; } return true; }
};
struct OrderWeff {
    int G, c;
    __device__ __forceinline__ bool next(int i, Unit& u) const {
        const int L = i * G + c; if (L >= 128) return false;
        const int layer = L >> 5, g = (L >> 3) & 3, pm = L & 7;
        u.pm = pm; u.pn = 0; u.pz = layer * 4 + g;
        u.aoff = (long)layer * 2048 * 1024 + (long)g * 256 + (long)pm * 256 * 1024; u.boff = (long)(layer * 4 + g) * 65536; u.xrow = -1; u.xoff = u.aoff; return true;
    }
};

struct EpiGU {
    static constexpr bool PERM = true, HOOK = false, PRE = true;
    bf16_t* act; const u64* ss;
    __device__ __forceinline__ void pre(const Unit& u, int wr, int fr, unsigned (&rq)[8]) const {
#pragma unroll
        for (int i = 0; i < 8; ++i) rq[i] = ((const unsigned*)ss)[2 * (u.pm * BM + wr * 64 + fr + (i >> 2) * HALF + (i & 3) * 16) + 1]; }
    __device__ __forceinline__ void operator()(const f32x4 (&acc)[2][2][4][2], const Unit& u, int wr, int wc, int fr, int fq, const unsigned (&rq)[8]) const {
        const int row0 = u.pm * BM + wr * 64 + fr, col = u.pn * 128 + wc * 32 + 8 * fq;
#pragma unroll
        for (int ai = 0; ai < 2; ++ai)
#pragma unroll
            for (int m = 0; m < 4; ++m) { const int row = row0 + ai * HALF + m * 16; const float rs = rstd_of(rq[ai * 4 + m]);
                float o[8];
#pragma unroll
                for (int n = 0; n < 2; ++n)
#pragma unroll
                    for (int j = 0; j < 4; ++j) { const float g = acc[ai][0][m][n][j] * rs, uu = acc[ai][1][m][n][j] * rs; o[n * 4 + j] = g * sigmoidf_(g) * uu; }
                u32x4 w; w.x = cvt_pk_bf16(o[0], o[1]); w.y = cvt_pk_bf16(o[2], o[3]); w.z = cvt_pk_bf16(o[4], o[5]); w.w = cvt_pk_bf16(o[6], o[7]);
                *(u32x4*)(act + (size_t)row * FF + col) = w; }
    }
};
struct EpiIn {
    static constexpr bool PERM = true, HOOK = false, PRE = true;
    bf16_t* Z; const u64* ss;
    __device__ __forceinline__ void pre(const Unit& u, int wr, int fr, unsigned (&rq)[8]) const {
#pragma unroll
        for (int i = 0; i < 8; ++i) rq[i] = ((const unsigned*)ss)[2 * (u.pm * BM + wr * 64 + fr + (i >> 2) * HALF + (i & 3) * 16) + 1]; }
    __device__ __forceinline__ void operator()(const f32x4 (&acc)[2][2][4][2], const Unit& u, int wr, int wc, int fr, int fq, const unsigned (&rq)[8]) const {
        const int row0 = u.pm * BM + wr * 64 + fr, col = u.pn * BM + wc * 32 + 8 * fq; const bool sig = u.pn >= 18;
#pragma unroll
        for (int ai = 0; ai < 2; ++ai)
#pragma unroll
            for (int m = 0; m < 4; ++m) { const int row = row0 + ai * HALF + m * 16; const float rs = rstd_of(rq[ai * 4 + m]);
#pragma unroll
                for (int bj = 0; bj < 2; ++bj) { float o[8];
#pragma unroll
                    for (int n = 0; n < 2; ++n)
#pragma unroll
                        for (int j = 0; j < 4; ++j) { float v = acc[ai][bj][m][n][j] * rs; if (sig) v = sigmoidf_(v); o[n * 4 + j] = v; }
                    u32x4 w; w.x = cvt_pk_bf16(o[0], o[1]); w.y = cvt_pk_bf16(o[2], o[3]); w.z = cvt_pk_bf16(o[4], o[5]); w.w = cvt_pk_bf16(o[6], o[7]);
                    *(u32x4*)(Z + (size_t)row * NIN + col + bj * HALF) = w; } }
    }
};
struct EpiRes {
    static constexpr bool PERM = true, HOOK = false, PRE = false;
    __device__ __forceinline__ void pre(const Unit&, int, int, unsigned (&)[8]) const {}
    float* Y; bf16_t* XB; u64* ssn; float scale;
    __device__ __forceinline__ float one8(const f32x4 a0, const f32x4 a1, unsigned off) const {
        const u32x4 xw = *(const u32x4*)(XB + off); f32x4 x0, x1;
        x0[0] = bf_lo(xw.x); x0[1] = bf_hi(xw.x); x0[2] = bf_lo(xw.y); x0[3] = bf_hi(xw.y); x1[0] = bf_lo(xw.z); x1[1] = bf_hi(xw.z); x1[2] = bf_lo(xw.w); x1[3] = bf_hi(xw.w);
        x0 = x0 + a0 * scale; x1 = x1 + a1 * scale; if (Y) { *(f32x4*)(Y + off) = x0; *(f32x4*)(Y + off + 4) = x1; }
        u32x4 w; w.x = cvt_pk_bf16(x0[0], x0[1]); w.y = cvt_pk_bf16(x0[2], x0[3]); w.z = cvt_pk_bf16(x1[0], x1[1]); w.w = cvt_pk_bf16(x1[2], x1[3]); *(u32x4*)(XB + off) = w;
        const float r0 = bf_lo(w.x), r1 = bf_hi(w.x), r2 = bf_lo(w.y), r3 = bf_hi(w.y), r4 = bf_lo(w.z), r5 = bf_hi(w.z), r6 = bf_lo(w.w), r7 = bf_hi(w.w);
        return ((r0 * r0 + r1 * r1) + (r2 * r2 + r3 * r3)) + ((r4 * r4 + r5 * r5) + (r6 * r6 + r7 * r7)); }
    __device__ __forceinline__ void operator()(const f32x4 (&acc)[2][2][4][2], const Unit& u, int wr, int wc, int fr, int fq, const unsigned (&)[8]) const {
        const int row0 = u.pm * BM + wr * 64 + fr, col0 = u.pn * BM + wc * 32 + 8 * fq;
#pragma unroll
        for (int ai = 0; ai < 2; ++ai)
#pragma unroll
            for (int mp = 0; mp < 2; ++mp) { const int rowa = row0 + ai * HALF + (2 * mp) * 16, rowb = rowa + 16; float sa = 0.f, sb = 0.f;
#pragma unroll
                for (int bj = 0; bj < 2; ++bj) sa += one8(acc[ai][bj][2 * mp][0], acc[ai][bj][2 * mp][1], (unsigned)rowa * (unsigned)D + (unsigned)(col0 + bj * HALF));
#pragma unroll
                for (int bj = 0; bj < 2; ++bj) sb += one8(acc[ai][bj][2 * mp + 1][0], acc[ai][bj][2 * mp + 1][1], (unsigned)rowb * (unsigned)D + (unsigned)(col0 + bj * HALF));
                u32x2v p = __builtin_amdgcn_permlane16_swap(__float_as_uint(sa), __float_as_uint(sb), false, false);
                const float t = __uint_as_float(p[0]) + __uint_as_float(p[1]);
                u32x2v q = __builtin_amdgcn_permlane32_swap(__float_as_uint(t), __float_as_uint(t), false, false);
                const float tot = __uint_as_float(q[0]) + __uint_as_float(q[1]);
                if (fq < 2) atomicAdd(ssn + (fq == 0 ? rowa : rowb), ss_fix(tot));
                asm volatile("" ::: "memory"); }
    }
    __device__ __forceinline__ void extra(const f32x4 (&accx)[2], const Unit& u, int wr, int wc, int fr, int fq) const {
        const int row = u.xrow + fr; float s = one8(accx[0], accx[1], (unsigned)row * (unsigned)D + (unsigned)(u.pn * BM + wr * HALF + wc * 32 + 8 * fq));
        s += __shfl_xor(s, 16); s += __shfl_xor(s, 32);
        if (fq == 0) atomicAdd(ssn + row, ss_fix(s));
    }
};
struct EpiBr {
    static constexpr bool PERM = true, HOOK = true, PRE = false;
    __device__ __forceinline__ void pre(const Unit&, int, int, unsigned (&)[8]) const {}
    const bf16_t* Z; bf16_t* MB;
    __device__ __forceinline__ void gate8(int row, int col, int z, f32x4& g0, f32x4& g1) const {
        const unsigned idx = (unsigned)row * (unsigned)NIN + (unsigned)(ZC_G + D * z + col); const u32x4 gw = *(const u32x4*)(Z + idx);
        g0[0] = bf_lo(gw.x); g0[1] = bf_hi(gw.x); g0[2] = bf_lo(gw.y); g0[3] = bf_hi(gw.y); g1[0] = bf_lo(gw.z); g1[1] = bf_hi(gw.z); g1[2] = bf_lo(gw.w); g1[3] = bf_hi(gw.w); }
    __device__ __forceinline__ void ratio8(int row, int col, int z, f32x4& r0, f32x4& r1) const {
        f32x4 a0, a1, b0, b1; gate8(row, col, z, a0, a1); gate8(row, col, z + 1, b0, b1);
#pragma unroll
        for (int j = 0; j < 4; ++j) { r0[j] = a0[j] * __builtin_amdgcn_rcpf(fmaxf(b0[j], 5.9604645e-08f)); r1[j] = a1[j] * __builtin_amdgcn_rcpf(fmaxf(b1[j], 5.9604645e-08f)); } }
    __device__ __forceinline__ bool hook_at(int t) const { return t == 16 || t == 32; }
    __device__ __forceinline__ void mid(f32x4 (&acc)[2][2][4][2], f32x4 (&accx)[2], const Unit& u, int t, int wr, int wc, int fr, int fq) const {
        const int z = (t >> 4) - 1, row0 = u.pm * BM + wr * 64 + fr, col0 = u.pn * BM + wc * 32 + 8 * fq;
#pragma unroll
        for (int ai = 0; ai < 2; ++ai) {
#pragma unroll
            for (int m = 0; m < 4; ++m) { const int row = row0 + ai * HALF + m * 16;
#pragma unroll
                for (int bj = 0; bj < 2; ++bj) { f32x4 r0, r1; ratio8(row, col0 + bj * HALF, z, r0, r1); acc[ai][bj][m][0] = acc[ai][bj][m][0] * r0; acc[ai][bj][m][1] = acc[ai][bj][m][1] * r1; } }
#pragma unroll
            for (int m = 0; m < 4; ++m) asm volatile("" : "+v"(acc[ai][0][m][0]), "+v"(acc[ai][0][m][1]), "+v"(acc[ai][1][m][0]), "+v"(acc[ai][1][m][1]) :: "memory"); }
        if (u.xrow >= 0) { f32x4 r0, r1; ratio8(u.xrow + fr, u.pn * BM + wr * HALF + wc * 32 + 8 * fq, z, r0, r1); accx[0] = accx[0] * r0; accx[1] = accx[1] * r1; }
    }
    __device__ __forceinline__ void put8(int row, int col, const f32x4 a0, const f32x4 a1) const {
        f32x4 g0, g1; gate8(row, col, 2, g0, g1); const f32x4 v0 = g0 * a0, v1 = g1 * a1;
        u32x4 w; w.x = cvt_pk_bf16(v0[0], v0[1]); w.y = cvt_pk_bf16(v0[2], v0[3]); w.z = cvt_pk_bf16(v1[0], v1[1]); w.w = cvt_pk_bf16(v1[2], v1[3]);
        *(u32x4*)(MB + ((unsigned)row * (unsigned)D + (unsigned)col)) = w; }
    __device__ __forceinline__ void operator()(const f32x4 (&acc)[2][2][4][2], const Unit& u, int wr, int wc, int fr, int fq, const unsigned (&)[8]) const {
        const int row0 = u.pm * BM + wr * 64 + fr, col0 = u.pn * BM + wc * 32 + 8 * fq;
#pragma unroll
        for (int ai = 0; ai < 2; ++ai)
#pragma unroll
            for (int m = 0; m < 4; ++m) { const int row = row0 + ai * HALF + m * 16;
#pragma unroll
                for (int bj = 0; bj < 2; ++bj) put8(row, col0 + bj * HALF, acc[ai][bj][m][0], acc[ai][bj][m][1]);
                asm volatile("" ::: "memory"); }
    }
    __device__ __forceinline__ void extra(const f32x4 (&accx)[2], const Unit& u, int wr, int wc, int fr, int fq) const {
        put8(u.xrow + fr, u.pn * BM + wr * HALF + wc * 32 + 8 * fq, accx[0], accx[1]);
    }
};
struct EpiWeff {
    static constexpr bool PERM = true, HOOK = false, PRE = false;
    __device__ __forceinline__ void pre(const Unit&, int, int, unsigned (&)[8]) const {}
    bf16_t* WS;
    __device__ __forceinline__ void operator()(const f32x4 (&acc)[2][2][4][2], const Unit& u, int wr, int wc, int fr, int fq, const unsigned (&)[8]) const {
        const int layer = u.pz >> 2, g = u.pz & 3;
        bf16_t* O = (bf16_t*)((char*)WS + (size_t)layer * LW_STRIDE) + g * 256;
        const int row0 = u.pm * BM + wr * 64 + fr, col = wc * 32 + 8 * fq;
#pragma unroll
        for (int ai = 0; ai < 2; ++ai)
#pragma unroll
            for (int m = 0; m < 4; ++m) { const int row = row0 + ai * HALF + m * 16;
#pragma unroll
                for (int bj = 0; bj < 2; ++bj) { const f32x4 v0 = acc[ai][bj][m][0], v1 = acc[ai][bj][m][1];
                    u32x4 w; w.x = cvt_pk_bf16(v0[0], v0[1]); w.y = cvt_pk_bf16(v0[2], v0[3]); w.z = cvt_pk_bf16(v1[0], v1[1]); w.w = cvt_pk_bf16(v1[2], v1[3]);
                    *(u32x4*)(O + (size_t)row * NBR + col + bj * HALF) = w; } }
    }
};

constexpr int XOFF = RING_BYTES + 2048;
template <bool XR, class Epi, class Sched>
__device__ __forceinline__ void gemm_phase(LAS unsigned char* lds, const Gemm g, const Sched& S, const Epi& E) {
    int tid = threadIdx.x; asm volatile("" : "+v"(tid));
    const int wid = __builtin_amdgcn_readfirstlane(tid >> 6), lane = tid & 63, wr = wid >> 2, wc = wid & 3, fr = lane & 15, fq = lane >> 4;
    int nt = g.K / BK; asm volatile("" : "+s"(nt));
    unsigned voffA, voffB, voffX = 0;
    { int R, C; stage_rc(tid * 16, R, C); const int Rb = Epi::PERM ? ((R & ~31) + perm32(R & 31)) : R;
      voffA = (unsigned)(R * g.lda + C) * 2u; voffB = (unsigned)(Rb * g.ldb + C) * 2u; }
    const size_t r64A = (size_t)64 * g.lda * 2, r64B = (size_t)64 * g.ldb * 2;
    if (XR) { int R, C; stage_rc(tid * 4, R, C); voffX = (unsigned)(R * g.lda + C) * 2u; }
    const size_t kstep = (size_t)(BK * 2);
    const size_t hstepA = (size_t)HALF * g.lda * 2, hstepB = (size_t)HALF * g.ldb * 2;
    const unsigned ldsw = (unsigned)wid * 1024u;
    const int aoff = lds_byte(wr * 64 + fr, fq * 8), boff = lds_byte(wc * 32 + fr, fq * 8), xoffr = lds_byte(fr, fq * 8);
#define PG8_SA(b, h) (((b) * 2 + (h)) * HTB)
#define PG8_SB(b, h) ((4 + (b) * 2 + (h)) * HTB)
#define PG8_STAGE(bufoff, gbase, voff) do { _Pragma("unroll") for (int _i = 0; _i < 2; ++_i) \
        __builtin_amdgcn_global_load_lds((const unsigned*)((const char*)(gbase) + (_i ? PG8_R64_##voff : (size_t)0) + (voff)), (LAS unsigned*)(lds + (bufoff) + ldsw + _i * 8192), 16, 0, 0); } while (0)
#define PG8_R64_voffA r64A
#define PG8_R64_voffB r64B
#define PG8_STAGEX(b, gbase) do { if (XR) __builtin_amdgcn_global_load_lds((const unsigned*)((const char*)(gbase) + voffX), (LAS unsigned*)(lds + XOFF + (b) * 2048 + (unsigned)wid * 256u), 4, 0, 0); } while (0)
#define PG8_LDA(dst, b, h) do { _Pragma("unroll") for (int m = 0; m < 4; ++m) _Pragma("unroll") for (int k = 0; k < 2; ++k) dst[m][k] = *(const LAS bf16x8*)(lds + PG8_SA(b, h) + aoff + m * 2048 + k * 1024); } while (0)
#define PG8_LDB(dst, b, h) do { _Pragma("unroll") for (int n = 0; n < 2; ++n) _Pragma("unroll") for (int k = 0; k < 2; ++k) dst[n][k] = *(const LAS bf16x8*)(lds + PG8_SB(b, h) + boff + n * 2048 + k * 1024); } while (0)
#define PG8_LDX(b) do { if (XR && hasx) { _Pragma("unroll") for (int k = 0; k < 2; ++k) Ax[k] = *(const LAS bf16x8*)(lds + XOFF + (b) * 2048 + xoffr + k * 1024); } } while (0)
#define PG8_MMA(ai, bj, At, Bt) do { __builtin_amdgcn_s_setprio(1); _Pragma("unroll") for (int m = 0; m < 4; ++m) _Pragma("unroll") for (int n = 0; n < 2; ++n) _Pragma("unroll") for (int k = 0; k < 2; ++k) \
        acc[ai][bj][m][n] = __builtin_amdgcn_mfma_f32_16x16x32_bf16(Bt[n][k], At[m][k], acc[ai][bj][m][n], 0, 0, 0); __builtin_amdgcn_s_setprio(0); } while (0)
#define PG8_MMAX() do { if (XR && hasx) { if (wr == 0) { _Pragma("unroll") for (int n = 0; n < 2; ++n) _Pragma("unroll") for (int k = 0; k < 2; ++k) accx[n] = __builtin_amdgcn_mfma_f32_16x16x32_bf16(B0[n][k], Ax[k], accx[n], 0, 0, 0); } \
        else { _Pragma("unroll") for (int n = 0; n < 2; ++n) _Pragma("unroll") for (int k = 0; k < 2; ++k) accx[n] = __builtin_amdgcn_mfma_f32_16x16x32_bf16(B1[n][k], Ax[k], accx[n], 0, 0, 0); } } } while (0)
#define PG8_WAIT_V(n) asm volatile("s_waitcnt vmcnt(" #n ")" ::: "memory")
#define PG8_WAIT_VL() do { if (XR) PG8_WAIT_V(9); else PG8_WAIT_V(8); } while (0)
#define PG8_WAIT_L(n) asm volatile("s_waitcnt lgkmcnt(" #n ")" ::: "memory")
#define PG8_BAR __builtin_amdgcn_s_barrier()
#define PG8_SCHED __builtin_amdgcn_sched_barrier(0)
    Unit cur, nxt; int ui = 0;
    if (!S.next(0, cur)) return;
    f32x4 acc[2][2][4][2], accx[2];
#pragma unroll
    for (int a = 0; a < 2; ++a)
#pragma unroll
        for (int b = 0; b < 2; ++b)
#pragma unroll
            for (int m = 0; m < 4; ++m)
#pragma unroll
                for (int n = 0; n < 2; ++n) acc[a][b][m][n] = (f32x4){0.f, 0.f, 0.f, 0.f};
    accx[0] = (f32x4){0.f, 0.f, 0.f, 0.f}; accx[1] = (f32x4){0.f, 0.f, 0.f, 0.f};
    bf16x8 At[4][2], B0[2][2], B1[2][2], Ax[2]; unsigned rq[8] = {0, 0, 0, 0, 0, 0, 0, 0};
    const char* cA = (const char*)(g.A + cur.aoff); const char* cB = (const char*)(g.Bt + cur.boff); const char* cX = (const char*)(g.A + cur.xoff);
    PG8_STAGE(PG8_SB(0, 0), cB, voffB); PG8_STAGE(PG8_SB(0, 1), cB + hstepB, voffB); PG8_STAGE(PG8_SA(0, 0), cA, voffA); PG8_STAGEX(0, cX); PG8_STAGE(PG8_SA(0, 1), cA + hstepA, voffA);
    if (wr == 1) PG8_BAR;
    PG8_WAIT_V(2); PG8_BAR;
    PG8_STAGE(PG8_SB(1, 0), cB + kstep, voffB); PG8_STAGE(PG8_SA(1, 0), cA + kstep, voffA); PG8_STAGE(PG8_SB(1, 1), cB + hstepB + kstep, voffB); PG8_STAGEX(1, cX + kstep);
    if (XR) PG8_WAIT_V(7); else PG8_WAIT_V(6);
    PG8_BAR;
    for (;;) {
        const bool has_next = S.next(ui + 1, nxt);
        const char* nA = has_next ? (const char*)(g.A + nxt.aoff) : cA; const char* nB = has_next ? (const char*)(g.Bt + nxt.boff) : cB; const char* nX = has_next ? (const char*)(g.A + nxt.xoff) : cX;
        const bool hasx = XR && cur.xrow >= 0;
        for (int t = 0; t < nt; t += 2) {
            const bool last = (t == nt - 2);
            const char* a1 = cA + (size_t)(t + 1) * kstep;
            const char* a2 = last ? nA : cA + (size_t)(t + 2) * kstep; const char* b2 = last ? nB : cB + (size_t)(t + 2) * kstep; const char* x2 = last ? nX : cX + (size_t)(t + 2) * kstep;
            const char* a3 = a2 + kstep; const char* b3 = b2 + kstep; const char* x3 = x2 + kstep;
            if constexpr (Epi::PRE) { if (last) { int tz = threadIdx.x; asm volatile("" : "+v"(tz)); const int wz = __builtin_amdgcn_readfirstlane(tz >> 6); E.pre(cur, wz >> 2, tz & 15, rq); } }
            if constexpr (Epi::HOOK) { if (E.hook_at(t)) { int tz = threadIdx.x; asm volatile("" : "+v"(tz));
                const int wz = __builtin_amdgcn_readfirstlane(tz >> 6); E.mid(acc, accx, cur, t, wz >> 2, wz & 3, tz & 15, (tz & 63) >> 4); } }
            PG8_LDB(B0, 0, 0); PG8_LDB(B1, 0, 1); PG8_SCHED; PG8_LDA(At, 0, 0); PG8_LDX(0); PG8_STAGE(PG8_SA(1, 1), a1 + hstepA, voffA);
            PG8_WAIT_VL(); PG8_WAIT_L(0); PG8_BAR; PG8_MMA(0, 0, At, B0); PG8_MMA(0, 1, At, B1); PG8_MMAX(); PG8_BAR; PG8_SCHED;
            PG8_LDA(At, 0, 1); PG8_STAGE(PG8_SB(0, 0), b2, voffB); PG8_STAGE(PG8_SB(0, 1), b2 + hstepB, voffB); PG8_STAGE(PG8_SA(0, 0), a2, voffA); PG8_STAGEX(0, x2);
            PG8_WAIT_VL(); PG8_WAIT_L(0); PG8_BAR; PG8_MMA(1, 0, At, B0); PG8_MMA(1, 1, At, B1); PG8_BAR; PG8_SCHED;
            PG8_LDB(B0, 1, 0); PG8_LDB(B1, 1, 1); PG8_SCHED; PG8_LDA(At, 1, 0); PG8_LDX(1); PG8_STAGE(PG8_SA(0, 1), a2 + hstepA, voffA);
            PG8_WAIT_VL(); PG8_WAIT_L(0); PG8_BAR; PG8_MMA(0, 0, At, B0); PG8_MMA(0, 1, At, B1); PG8_MMAX(); PG8_BAR; PG8_SCHED;
            PG8_LDA(At, 1, 1); PG8_STAGE(PG8_SB(1, 0), b3, voffB); PG8_STAGE(PG8_SB(1, 1), b3 + hstepB, voffB); PG8_STAGE(PG8_SA(1, 0), a3, voffA); PG8_STAGEX(1, x3);
            PG8_WAIT_VL(); PG8_WAIT_L(0); PG8_BAR; PG8_MMA(1, 0, At, B0); PG8_MMA(1, 1, At, B1); PG8_BAR; PG8_SCHED;
        }
        if (wr == 0) PG8_BAR;
        { int tz = threadIdx.x; asm volatile("" : "+v"(tz)); const int wz = __builtin_amdgcn_readfirstlane(tz >> 6), ewr = wz >> 2, ewc = wz & 3, efr = tz & 15, efq = (tz & 63) >> 4;
          E(acc, cur, ewr, ewc, efr, efq, rq);
          if constexpr (XR) { if (cur.xrow >= 0) E.extra(accx, cur, ewr, ewc, efr, efq); } }
        if (!has_next) break;
#pragma unroll
        for (int a = 0; a < 2; ++a)
#pragma unroll
            for (int b = 0; b < 2; ++b)
#pragma unroll
                for (int m = 0; m < 4; ++m)
#pragma unroll
                    for (int n = 0; n < 2; ++n) acc[a][b][m][n] = (f32x4){0.f, 0.f, 0.f, 0.f};
        accx[0] = (f32x4){0.f, 0.f, 0.f, 0.f}; accx[1] = (f32x4){0.f, 0.f, 0.f, 0.f};
        cur = nxt; cA = nA; cB = nB; cX = nX; ++ui;
        if (wr == 1) PG8_BAR;
    }
    PG8_WAIT_V(0);
    PG8_BAR;
#undef PG8_SA
#undef PG8_SB
#undef PG8_STAGE
#undef PG8_R64_voffA
#undef PG8_R64_voffB
#undef PG8_STAGEX
#undef PG8_LDA
#undef PG8_LDB
#undef PG8_LDX
#undef PG8_MMA
#undef PG8_MMAX
#undef PG8_WAIT_V
#undef PG8_WAIT_VL
#undef PG8_WAIT_L
#undef PG8_BAR
#undef PG8_SCHED
}
}

#define XB_TMO      128
#define XB_XCNT(j)  (256  + 64 * (j))
#define XB_XSUB(j)  (1280 + 64 * (j))
#define XB_XGEN(j)  (2304 + 64 * (j))
#define XB_TOP      3328
#define XB_TOPGEN   3392
#define XCD_BAR_WORDS 3456
#define XB_SPIN_CAP (1u << 18)
__device__ __forceinline__ unsigned xb_ld(unsigned* p)              { return __hip_atomic_load(p, __ATOMIC_RELAXED, __HIP_MEMORY_SCOPE_AGENT); }
__device__ __forceinline__ unsigned xb_add(unsigned* p, unsigned v) { return __hip_atomic_fetch_add(p, v, __ATOMIC_RELAXED, __HIP_MEMORY_SCOPE_AGENT); }
__device__ __forceinline__ unsigned xb_xcc_id() { return (unsigned)__builtin_amdgcn_s_getreg((3 << 11) | 20) & 0xFu; }
#define XB_SPIN(cond, bar) do { unsigned _sp = 0; while (cond) { __builtin_amdgcn_s_sleep(1); \
    if ((++_sp & 255u) == 0u) { if (xb_ld(&(bar)[XB_TMO])) break; if (_sp > XB_SPIN_CAP) { atomicAdd(&(bar)[XB_TMO], 1u); break; } } } } while (0)
struct XcdBarrier { unsigned* bar; unsigned x; volatile LAS unsigned* st; };
__device__ __forceinline__ XcdBarrier xcd_barrier_post(unsigned* bar, volatile LAS unsigned* st) {
    XcdBarrier b; b.bar = bar; b.x = xb_xcc_id(); b.st = st;
    if (threadIdx.x == 0) (void)xb_add(&bar[XB_XCNT(b.x)], 1u);
    return b;
}
__device__ __forceinline__ void xcd_barrier_complete(unsigned* bar, unsigned x, unsigned& nloc, unsigned& nx) {
    const unsigned G = gridDim.x * gridDim.y * gridDim.z;
    unsigned sum, cnt, mine, sp = 0u;
    for (;;) {
        sum = 0u; cnt = 0u; mine = 0u;
#pragma unroll
        for (unsigned j = 0; j < 16; ++j) { const unsigned c = xb_ld(&bar[XB_XCNT(j)]); sum += c; cnt += (c > 0u) ? 1u : 0u; mine = (j == x) ? c : mine; }
        if (sum == G) break;
        __builtin_amdgcn_s_sleep(1);
        if ((++sp & 255u) == 0u) { if (xb_ld(&bar[XB_TMO])) break; if (sp > XB_SPIN_CAP) { atomicAdd(&bar[XB_TMO], 1u); break; } }
    }
    nloc = mine > 0u ? mine : 1u; nx = cnt > 0u ? cnt : 1u;
}
__device__ __forceinline__ void xcd_barrier(const XcdBarrier& b) {
    asm volatile("s_waitcnt vmcnt(0)" ::: "memory");
    __syncthreads();
    if (threadIdx.x == 0) {
        unsigned* bar = b.bar;
        __builtin_amdgcn_s_waitcnt(0);
        unsigned nloc = b.st[0], nx = b.st[1];
        if (nloc == 0u) { xcd_barrier_complete(bar, b.x, nloc, nx); b.st[0] = nloc; b.st[1] = nx; }
        const unsigned old = xb_add(&bar[XB_XSUB(b.x)], 1u);
        const unsigned gen = old / nloc;
        if (old + 1u == (gen + 1u) * nloc) {
            __builtin_amdgcn_fence(__ATOMIC_RELEASE, "agent");
            asm volatile("s_waitcnt vmcnt(0)" ::: "memory");
            const unsigned og = xb_add(&bar[XB_TOP], 1u);
            const unsigned tg = og / nx;
            if (og + 1u == (tg + 1u) * nx) xb_add(&bar[XB_TOPGEN], 1u);
            else XB_SPIN(xb_ld(&bar[XB_TOPGEN]) == tg, bar);
            __builtin_amdgcn_fence(__ATOMIC_ACQUIRE, "agent");
            xb_add(&bar[XB_XGEN(b.x)], 1u);
            asm volatile("s_waitcnt vmcnt(0)" ::: "memory");
        } else {
            XB_SPIN(xb_ld(&bar[XB_XGEN(b.x)]) == gen, bar);
            __builtin_amdgcn_fence(__ATOMIC_ACQUIRE, "agent");
            asm volatile("s_waitcnt vmcnt(0)" ::: "memory");
        }
    }
    __syncthreads();
}

struct Args { const float* in[31]; float* out; unsigned char* ws; int ph_lo, ph_hi; };
static_assert(sizeof(Args) == 31 * 8 + 8 + 8 + 8, "Args has no padding");

struct Ctx {
    const float* const* tbl; unsigned char* ws; float* out; int l;
    __device__ __forceinline__ const GAS float* in(int i) const { return (const GAS float*)tbl[i]; }
    __device__ __forceinline__ const bf16_t* Z() const { return (const bf16_t*)(ws + WS_Z); }
    __device__ __forceinline__ bf16_t* BR() const { return (bf16_t*)(ws + WS_BR); }
    __device__ __forceinline__ const float* rope() const { return (const float*)(ws + WS_ROPE); }
    __device__ __forceinline__ float* summ() const { return (float*)(ws + WS_SUMM); }
    __device__ __forceinline__ const GAS float* qn() const { return in(14) + l * 64; }
    __device__ __forceinline__ const GAS float* kn() const { return in(15) + l * 64; }
    __device__ __forceinline__ const GAS float* sinks() const { return in(16) + l * 16; }
    __device__ __forceinline__ const GAS float* cache_k() const { return in(3) + (size_t)l * 32 * 128 * 256; }
    __device__ __forceinline__ const GAS float* cache_v() const { return in(4) + (size_t)l * 32 * 128 * 256; }
    __device__ __forceinline__ const GAS float* state_pool() const { return in(2) + (size_t)l * 32 * 15 * 1024; }
    __device__ __forceinline__ const GAS float* state_conv() const { return in(5) + (size_t)l * 32 * 3 * 1024; }
    __device__ __forceinline__ const GAS float* state_h() const { return in(6) + (size_t)l * 32 * 1024; }
    __device__ __forceinline__ const GAS float* conv_w() const { return in(17) + l * 4096; }
    __device__ __forceinline__ const GAS float* conv_b() const { return in(18) + l * 1024; }
    __device__ __forceinline__ const GAS float* ba() const { return in(20) + l * 1024; }
    __device__ __forceinline__ const GAS float* bx() const { return in(22) + l * 1024; }
    __device__ __forceinline__ const GAS float* lam() const { return in(23) + l * 1024; }
    __device__ __forceinline__ const bf16_t* WaT() const { return (const bf16_t*)(ws + WS_GATE) + (size_t)(l * 2 + 0) * 65536; }
    __device__ __forceinline__ const bf16_t* WxT() const { return (const bf16_t*)(ws + WS_GATE) + (size_t)(l * 2 + 1) * 65536; }
    __device__ __forceinline__ float* o_pool(int sample) const { return out + (sample ? O_POOL_S + (size_t)l * 32 * 15 * 1024 : O_POOL_P + (size_t)l * 4 * 15 * 1024); }
    __device__ __forceinline__ float* o_k(int sample) const { return out + (sample ? O_K_S + (size_t)l * 32 * 128 * 256 : O_K_P + (size_t)l * 4 * 128 * 256); }
    __device__ __forceinline__ float* o_v(int sample) const { return out + (sample ? O_V_S + (size_t)l * 32 * 128 * 256 : O_V_P + (size_t)l * 4 * 128 * 256); }
    __device__ __forceinline__ float* o_conv(int sample) const { return out + (sample ? O_CONV_S + (size_t)l * 32 * 3 * 1024 : O_CONV_P + (size_t)l * 4 * 3 * 1024); }
    __device__ __forceinline__ float* o_h(int sample) const { return out + (sample ? O_H_S + (size_t)l * 32 * 1024 : O_H_P + (size_t)l * 4 * 1024); }
};

struct TDesc { const GAS float* src; const GAS float* gain; GAS bf16_t* dst; int ldw, ldo; };
__device__ __forceinline__ int gu_rowmap(int n0) { return n0 < FF ? 256 * (n0 >> 7) + (n0 & 127) : 256 * ((n0 - FF) >> 7) + 128 + ((n0 - FF) & 127); }
constexpr int TT_GU = (D / 64) * (NGU / 64), TT_DN = (FF / 64) * (D / 64), TT_IN = (D / 64) * (NIN / 64), TT_BR = (1024 / 64) * (D / 64), TT_OUT = (D / 64) * (D / 64), TT_GT = 32;
constexpr int TT_LAYER = 2 * TT_GU + 2 * TT_DN + TT_IN + 3 * TT_BR + TT_OUT + TT_GT;
struct PSArgs { const Args* a; __device__ __forceinline__ const float* operator()(int i) const { return a->in[i]; } };
struct PSTbl { const float* const* t; __device__ __forceinline__ const float* operator()(int i) const { return (const float*)(const GAS float*)t[i]; } };
constexpr int TT_STREAM = TT_LAYER - TT_BR, TT_B0 = DEPTH * TT_BR, TT_TOTAL = TT_B0 + DEPTH * TT_STREAM;
__host__ __device__ constexpr int tt_need(int l, int j) {
    int c = TT_GU; if (j >= 1) c += TT_DN; if (j >= 2) c += TT_IN; if (j >= 3) c += TT_GT + 2 * TT_BR; if (j >= 5) c += TT_OUT; if (j >= 6) c += TT_GU; if (j >= 7) c += TT_DN;
    return TT_B0 + l * TT_STREAM + c; }
static_assert(tt_need(DEPTH - 1, 7) == TT_TOTAL, "tile stream");
template <class PS>
__device__ __forceinline__ TDesc tr_decode(const PS& P, unsigned char* ws, int it) {
    TDesc d; d.gain = nullptr;
#define TT_SET(SRC, LDW, DST, LDO, OROW, OCOL, K0, N0) do { d.src = (const GAS float*)((SRC) + (size_t)(K0) * (LDW) + (N0)); d.ldw = (LDW); d.dst = (GAS bf16_t*)((DST) + (size_t)(OROW) * (LDO) + (OCOL) + (K0)); d.ldo = (LDO); } while (0)
    if (it < TT_B0) { const int l = it / TT_BR, r = it - l * TT_BR; const int kb = r / (D / 64), nb = r - kb * (D / 64);
        TT_SET(P(24) + (size_t)l * 1024 * D, D, (bf16_t*)(ws + WS_WBPT) + (size_t)l * D * 1024, 1024, 64 * nb, 0, 64 * kb, 64 * nb); return d; }
    it -= TT_B0;
    const int l = it / TT_STREAM; int r = it - l * TT_STREAM;
    unsigned char* lw = ws + WS_W + (size_t)l * LW_STRIDE;
    if (r < TT_GU) { const int kb = r / (NGU / 64), nb = r - kb * (NGU / 64); TT_SET(P(8) + (size_t)l * D * NGU, NGU, (bf16_t*)(lw + LW_GUA), D, gu_rowmap(64 * nb), 0, 64 * kb, 64 * nb); d.gain = (const GAS float*)(P(7) + l * D + 64 * kb); return d; } r -= TT_GU;
    if (r < TT_DN) { const int kb = r / (D / 64), nb = r - kb * (D / 64); TT_SET(P(9) + (size_t)l * FF * D, D, (bf16_t*)(lw + LW_DNA), FF, 64 * nb, 0, 64 * kb, 64 * nb); return d; } r -= TT_DN;
    if (r < TT_IN) { const int kb = r / (NIN / 64), nb = r - kb * (NIN / 64); TT_SET(P(11) + (size_t)l * D * NIN, NIN, (bf16_t*)(lw + LW_IN), D, 64 * nb, 0, 64 * kb, 64 * nb); d.gain = (const GAS float*)(P(10) + l * D + 64 * kb); return d; } r -= TT_IN;
    if (r < TT_GT) { const int gate = r >> 4, h = r & 15; TT_SET(P(gate ? 21 : 19) + (size_t)l * 65536 + h * 4096, 64, (bf16_t*)(ws + WS_GATE) + (size_t)((l * 2 + gate) * 16 + h) * 4096, 64, 0, 0, 0, 0); return d; } r -= TT_GT;
    if (r < TT_BR) { const int kb = r / (D / 64), nb = r - kb * (D / 64); TT_SET(P(25) + (size_t)l * 1024 * D, D, (bf16_t*)(lw + LW_CAT), NBR, 64 * nb, BRC_ATT, 64 * kb, 64 * nb); return d; } r -= TT_BR;
    if (r < TT_BR) { const int kb = r / (D / 64), nb = r - kb * (D / 64); TT_SET(P(26) + (size_t)l * 1024 * D, D, (bf16_t*)(lw + LW_CAT), NBR, 64 * nb, BRC_LRU, 64 * kb, 64 * nb); return d; } r -= TT_BR;
    if (r < TT_OUT) { const int kb = r / (D / 64), nb = r - kb * (D / 64); TT_SET(P(27) + (size_t)l * D * D, D, (bf16_t*)(lw + LW_OUT), D, 64 * nb, 0, 64 * kb, 64 * nb); return d; } r -= TT_OUT;
    if (r < TT_GU) { const int kb = r / (NGU / 64), nb = r - kb * (NGU / 64); TT_SET(P(29) + (size_t)l * D * NGU, NGU, (bf16_t*)(lw + LW_GUB), D, gu_rowmap(64 * nb), 0, 64 * kb, 64 * nb); d.gain = (const GAS float*)(P(28) + l * D + 64 * kb); return d; } r -= TT_GU;
    { const int kb = r / (D / 64), nb = r - kb * (D / 64); TT_SET(P(30) + (size_t)l * FF * D, D, (bf16_t*)(lw + LW_DNB), FF, 64 * nb, 0, 64 * kb, 64 * nb); }
#undef TT_SET
    return d;
}
__device__ __forceinline__ void tr_load(const TDesc& d, f32x4 (&v)[16], int lane) {
    const GAS float* p = d.src + (size_t)(2 * (lane >> 4)) * d.ldw + 4 * (lane & 15);
#pragma unroll
    for (int i = 0; i < 8; ++i) { v[2 * i] = *(const GAS f32x4*)(p + (size_t)(8 * i) * d.ldw); v[2 * i + 1] = *(const GAS f32x4*)(p + (size_t)(8 * i + 1) * d.ldw); }
}
__device__ __forceinline__ void tr_store(const TDesc& d, const f32x4 (&v)[16], LAS unsigned char* img, int lane) {
    const int n4 = lane & 15, kpl = lane >> 4;
#pragma unroll
    for (int i = 0; i < 8; ++i) { float g0 = 1.f, g1 = 1.f; if (d.gain) { g0 = d.gain[2 * (kpl + 4 * i)]; g1 = d.gain[2 * (kpl + 4 * i) + 1]; }
#pragma unroll
        for (int e = 0; e < 4; ++e) *(LAS unsigned*)(img + (4 * n4 + e) * 128 + ((i ^ (n4 & 7)) << 4) + kpl * 4) = cvt_pk_bf16(v[2 * i][e] * g0, v[2 * i + 1][e] * g1); }
    LDS_WAIT();
#pragma unroll
    for (int j = 0; j < 8; ++j) { const int idx = lane + 64 * j, n = idx >> 3, c = idx & 7;
        const u32x4 w = *(const LAS u32x4*)(img + n * 128 + ((c ^ ((n >> 2) & 7)) << 4));
        *(GAS u32x4*)(d.dst + (size_t)n * d.ldo + 8 * c) = w; }
    LDS_WAIT();
}


constexpr int CW_SPTR = 1024;
constexpr int TT_BASE0 = tt_need(0, 0);
template <class PS>
__device__ __forceinline__ void convert_range(const PS& P, unsigned char* ws, LAS unsigned char* img, int lane, int r0, int r1, int widx, int nw) {
    int it = r0 + widx; f32x4 va[16], vb[16]; TDesc da, db;
    if (it < r1) { da = tr_decode(P, ws, it); tr_load(da, va, lane); }
    while (it < r1) {
        const int it1 = it + nw; if (it1 < r1) { db = tr_decode(P, ws, it1); tr_load(db, vb, lane); }
        tr_store(da, va, img, lane);
        if (it1 >= r1) break;
        const int it2 = it1 + nw; if (it2 < r1) { da = tr_decode(P, ws, it2); tr_load(da, va, lane); }
        tr_store(db, vb, img, lane);
        it = it2; }
}
template <class PS>
__device__ __forceinline__ void convert_wg(const PS& P, unsigned char* ws, LAS unsigned char* lds, volatile LAS unsigned* st, unsigned* sp, int bound, int fixed) {
    int tz = threadIdx.x; asm volatile("" : "+v"(tz)); const int wz = __builtin_amdgcn_readfirstlane(tz >> 6), lz = tz & 63;
#pragma unroll 1
    for (;;) {
        if (tz == 0) { int base = -1, n = 0; const int cur = TT_BASE0 + (int)__hip_atomic_load(sp, __ATOMIC_RELAXED, __HIP_MEMORY_SCOPE_AGENT);
            if (cur < bound) { const int G_ = (int)gridDim.x; int want = fixed > 0 ? fixed : (bound - cur + G_ - 1) / G_; want = (want + 7) & ~7; n = want < 8 ? 8 : (want > 64 ? 64 : want);
                base = TT_BASE0 + (int)__hip_atomic_fetch_add(sp, (unsigned)n, __ATOMIC_RELAXED, __HIP_MEMORY_SCOPE_AGENT); }
            st[3] = (unsigned)base; st[4] = (unsigned)n; }
        __syncthreads();
        const int base = __builtin_amdgcn_readfirstlane((int)st[3]), n = __builtin_amdgcn_readfirstlane((int)st[4]);
        __syncthreads();
        if (base < 0 || base >= TT_TOTAL) break;
        const int end = (base + n) < TT_TOTAL ? (base + n) : TT_TOTAL;
        convert_range(P, ws, lds + wz * 8192, lz, base, end, wz, 8);
        if (fixed > 0) break;
    }
}
__device__ __forceinline__ void prologue(const Args& a, LAS unsigned char* lds, int gw, int NGW, int wave, int lane) {
    unsigned char* ws = a.ws;
    LAS unsigned char* img = lds + wave * 8192;
    if (gw == 0 && lane < 31) { const float* p = a.in[0];
#pragma unroll
        for (int q = 1; q < 31; ++q) p = (lane == q) ? a.in[q] : p;
        ((const float**)(ws + WS_TBL))[lane] = p; }
    { const PSArgs P{&a};
      convert_range(P, ws, img, lane, 0, TT_BASE0, gw, NGW); }
    { bf16_t* pp = (bf16_t*)(ws + WS_PP);
      for (int i = gw * 64 + lane; i < DEPTH * 4 * 65536 / 8; i += NGW * 64) { const int e = i * 8, lg = e >> 16, d0 = e & 255; const float* w = a.in[12] + e; const float* sc = a.in[13] + lg * 256 + d0;
          const f32x4 w0 = *(const f32x4*)w, w1 = *(const f32x4*)(w + 4), s0 = *(const f32x4*)sc, s1 = *(const f32x4*)(sc + 4);
          u32x4 o; o.x = cvt_pk_bf16(w0[0] * s0[0], w0[1] * s0[1]); o.y = cvt_pk_bf16(w0[2] * s0[2], w0[3] * s0[3]); o.z = cvt_pk_bf16(w1[0] * s1[0], w1[1] * s1[1]); o.w = cvt_pk_bf16(w1[2] * s1[2], w1[3] * s1[3]);
          *(u32x4*)(pp + e) = o; } }
    { bf16_t* XB = (bf16_t*)(ws + WS_XB); u64* ss0 = (u64*)(ws + WS_CTL + (size_t)CW_SS * 4);
      for (int row = gw; row < M; row += NGW) { const float* src = row < MP ? a.in[0] + (size_t)row * D : a.in[1] + (size_t)(row - MP) * D; float s = 0.f;
#pragma unroll
          for (int j = 0; j < 8; ++j) { const int c = 4 * lane + 256 * j; const f32x4 v = *(const f32x4*)(src + c);
              u32x2 w; w.x = cvt_pk_bf16(v[0], v[1]); w.y = cvt_pk_bf16(v[2], v[3]); *(u32x2*)(XB + (size_t)row * D + c) = w; s += (v[0] * v[0] + v[1] * v[1]) + (v[2] * v[2] + v[3] * v[3]); }
#pragma unroll
          for (int o = 1; o < 64; o <<= 1) s += __shfl_xor(s, o);
          if (lane == 0) ss0[row] = ss_fix(s); } }
    { float* rope = (float*)(ws + WS_ROPE);
      const float inv[8] = {1.0f, 1.939227432e-01f, 3.760603070e-02f, 7.292664610e-03f, 1.414213562e-03f, 2.742481884e-04f, 5.318296098e-05f, 1.031338616e-05f};
      for (int i = gw * 64 + lane; i < 2056 * 8; i += NGW * 64) { const int p = i >> 3, f = i & 7; const int pos = p < 2048 ? p : 16384 + (p - 2048);
          float iv = inv[0];
#pragma unroll
          for (int q = 1; q < 8; ++q) iv = (f == q) ? inv[q] : iv;
          const float ang = (float)pos * iv;
          double rev = (double)ang * 0.15915494309189535; rev -= __builtin_rint(rev);
          const float rv = (float)rev;
          rope[p * 16 + f] = __builtin_amdgcn_cosf(rv); rope[p * 16 + 8 + f] = __builtin_amdgcn_sinf(rv); } }
}

__device__ __forceinline__ void unpack8(const u32x4 w, float (&f)[16], int o) { f[o + 0] = bf_lo(w.x); f[o + 1] = bf_hi(w.x); f[o + 2] = bf_lo(w.y); f[o + 3] = bf_hi(w.y); f[o + 4] = bf_lo(w.z); f[o + 5] = bf_hi(w.z); f[o + 6] = bf_lo(w.w); f[o + 7] = bf_hi(w.w); }

constexpr int KS_STRIDE = 72, VT_STRIDE = 264, VT_OFF = 256 * KS_STRIDE * 2;
template <bool FULL>
__device__ __forceinline__ void attn_compute(const Ctx& C, LAS unsigned char* lds, const bf16_t* Z, int row0, int q0, int nq_, int nspan, int pidx0, int has_past, int kvh, int wid, int lane) {
    const int nq = FULL ? 128 : nq_;
    const int g = wid >> 1, qh = wid & 1, head = kvh * 4 + g, fr = lane & 15, fq = lane >> 4;
    constexpr float LOG2E = 1.4426950408889634f, SC = 0.125f * LOG2E;
    const int smin = has_past ? 0 : ((128 - q0) > 0 ? (128 - q0) : 0), smax = nspan - 1;
    const float sink2 = C.sinks()[head] * LOG2E;
    u32x4 qraw0 = (u32x4){0u, 0u, 0u, 0u}, qraw1 = (u32x4){0u, 0u, 0u, 0u};
    { const int qi0 = 64 * qh + fr; if (64 * qh < nq && qi0 < nq) { const bf16_t* qp = Z + (size_t)(row0 + q0 + qi0) * NIN + ZC_Q + head * 64 + 8 * fq; qraw0 = *(const u32x4*)qp; qraw1 = *(const u32x4*)(qp + 32); } }
#pragma unroll 1
    for (int qp = 0; qp < 2; ++qp) {
    if (!FULL && 64 * qh + 32 * qp >= nq) break;
#pragma unroll
    for (int q2 = 0; q2 < 2; ++q2) { const int qb = 2 * qp + q2;
        if (!FULL && 64 * qh + 16 * qb >= nq) break;
        const int qi = 64 * qh + 16 * qb + fr; const bool qv = qi < nq;
        bf16x8 qf[2];
        { float x[16];
          unpack8(qraw0, x, 0); unpack8(qraw1, x, 8);
          { qraw0 = (u32x4){0u, 0u, 0u, 0u}; qraw1 = (u32x4){0u, 0u, 0u, 0u};
            const int qn_ = qi + 16; if (qb < 3 && 64 * qh + 16 * (qb + 1) < nq && qn_ < nq) { const bf16_t* qp = Z + (size_t)(row0 + q0 + qn_) * NIN + ZC_Q + head * 64 + 8 * fq; qraw0 = *(const u32x4*)qp; qraw1 = *(const u32x4*)(qp + 32); } }
          float ss = 0.f;
#pragma unroll
          for (int j = 0; j < 16; ++j) ss += x[j] * x[j];
          ss = xsum_16_32(ss);
          const float rs = rsqrtf(ss * (1.0f / 64.0f) + RMS_EPS);
#pragma unroll
          for (int j = 0; j < 8; ++j) { x[j] = x[j] * rs * C.qn()[8 * fq + j]; x[8 + j] = x[8 + j] * rs * C.qn()[32 + 8 * fq + j]; }
          const float* rp = C.rope() + (size_t)(pidx0 + q0 + (qv ? qi : 0)) * 16;
#pragma unroll
          for (int j = 0; j < 8; ++j) { const float cs = rp[j], sn = rp[8 + j];
              u32x2v pr = __builtin_amdgcn_permlane16_swap(__float_as_uint(x[j]), __float_as_uint(x[j]), false, false); const float xe = __uint_as_float(pr[0]), xo = __uint_as_float(pr[1]);
              const float r0 = xe * cs - xo * sn, r1 = xo * cs + xe * sn; x[j] = (fq == 0) ? r0 : ((fq == 1) ? r1 : x[j]); }
          u32x4 w0, w1; w0.x = cvt_pk_bf16(x[0], x[1]); w0.y = cvt_pk_bf16(x[2], x[3]); w0.z = cvt_pk_bf16(x[4], x[5]); w0.w = cvt_pk_bf16(x[6], x[7]);
          w1.x = cvt_pk_bf16(x[8], x[9]); w1.y = cvt_pk_bf16(x[10], x[11]); w1.z = cvt_pk_bf16(x[12], x[13]); w1.w = cvt_pk_bf16(x[14], x[15]);
          qf[0] = __builtin_bit_cast(bf16x8, w0); qf[1] = __builtin_bit_cast(bf16x8, w1); }
        const int kbase = 64 * qh + 16 * qb;
        const int lo = qi > smin ? qi : smin, hi = (qi + 128) < smax ? (qi + 128) : smax;
        f32x4 S[9];
#pragma unroll
        for (int kb = 0; kb < 9; ++kb) { S[kb] = (f32x4){0.f, 0.f, 0.f, 0.f};
#pragma unroll
            for (int ks = 0; ks < 2; ++ks) { const bf16x8 kfr = *(const LAS bf16x8*)(lds + (kbase + 16 * kb + fr) * (KS_STRIDE * 2) + (32 * ks + 8 * fq) * 2);
                S[kb] = __builtin_amdgcn_mfma_f32_16x16x32_bf16(kfr, qf[ks], S[kb], 0, 0, 0); } }
        float mx = sink2;
        if (FULL && smin == 0) {
#pragma unroll
            for (int kb = 0; kb < 9; ++kb)
#pragma unroll
                for (int i = 0; i < 4; ++i) { const int sk = kbase + 16 * kb + 4 * fq + i; float v = S[kb][i] * SC; if (kb == 0 || kb == 8) v = (sk >= lo && sk <= hi) ? v : -1e30f; S[kb][i] = v; mx = fmaxf(mx, v); }
        } else {
#pragma unroll
        for (int kb = 0; kb < 9; ++kb)
#pragma unroll
            for (int i = 0; i < 4; ++i) { const int sk = kbase + 16 * kb + 4 * fq + i; float v = S[kb][i] * SC; v = (sk >= lo && sk <= hi) ? v : -1e30f; S[kb][i] = v; mx = fmaxf(mx, v); }
        }
        mx = xmax_16_32(mx);
        float lrow = (fq == 0) ? __builtin_amdgcn_exp2f(sink2 - mx) : 0.f;
#pragma unroll
        for (int kb = 0; kb < 9; ++kb)
#pragma unroll
            for (int i = 0; i < 4; ++i) { const float pv = __builtin_amdgcn_exp2f(S[kb][i] - mx); S[kb][i] = pv; lrow += pv; }
        f32x4 O[4];
#pragma unroll
        for (int db = 0; db < 4; ++db) O[db] = (f32x4){0.f, 0.f, 0.f, 0.f};
#pragma unroll
        for (int kk = 0; kk < 5; ++kk) { u32x4 pw; pw.x = cvt_pk_bf16(S[2 * kk][0], S[2 * kk][1]); pw.y = cvt_pk_bf16(S[2 * kk][2], S[2 * kk][3]);
            if (kk < 4) { pw.z = cvt_pk_bf16(S[2 * kk + 1][0], S[2 * kk + 1][1]); pw.w = cvt_pk_bf16(S[2 * kk + 1][2], S[2 * kk + 1][3]); } else { pw.z = 0u; pw.w = 0u; }
            const bf16x8 pf = __builtin_bit_cast(bf16x8, pw);
#pragma unroll
            for (int db = 0; db < 4; ++db) { const LAS unsigned char* vb = lds + VT_OFF + (16 * db + fr) * (VT_STRIDE * 2) + (kbase + 32 * kk + 4 * fq) * 2;
                const u32x2 v0 = *(const LAS u32x2*)vb, v1 = (kk < 4) ? *(const LAS u32x2*)(vb + 32) : v0;
                u32x4 vw; vw.x = v0.x; vw.y = v0.y; vw.z = v1.x; vw.w = v1.y;
                O[db] = __builtin_amdgcn_mfma_f32_16x16x32_bf16(__builtin_bit_cast(bf16x8, vw), pf, O[db], 0, 0, 0); } }
        const float lt = xsum_16_32(lrow); const float inv = 1.0f / lt;
        if (qv) { bf16_t* op = C.BR() + (size_t)(row0 + q0 + qi) * NBR + BRC_ATT + head * 64 + 4 * fq;
#pragma unroll
            for (int db = 0; db < 4; ++db) { const f32x4 o = O[db] * inv; u32x2 w; w.x = cvt_pk_bf16(o[0], o[1]); w.y = cvt_pk_bf16(o[2], o[3]); *(u32x2*)(op + 16 * db) = w; } }
    }
    }
}
__device__ __forceinline__ void attn_unit(const Ctx& C, LAS unsigned char* lds, int a, int tid, int wid, int lane) {
    int T, row0, pidx0, has_past, b, kvh, q0;
    if (a < 256) { b = a >> 6; kvh = (a >> 4) & 3; q0 = (a & 15) * 128; T = 2048; row0 = b * 2048; pidx0 = 0; has_past = 0; }
    else { const int a2 = a - 256; b = a2 >> 2; kvh = a2 & 3; q0 = 0; T = 8; row0 = MP + 8 * b; pidx0 = 2048; has_past = 1; }
    const int nq = (T - q0) < 128 ? (T - q0) : 128, nspan = 128 + nq;
    const bool lastblk = (q0 + nq == T);
    const bf16_t* Z = C.Z();
#pragma unroll 1
    for (int pass = 0; pass < 2; ++pass) {
        const int s = pass * 128 + (tid >> 2), p = tid & 3, tk = q0 - 128 + s;
        float kf[16], vf[16];
#pragma unroll
        for (int j = 0; j < 16; ++j) { kf[j] = 0.f; vf[j] = 0.f; }
        const bool fromz = (s < nspan) && (tk >= 0), frompast = (s < nspan) && (tk < 0) && has_past;
        if (fromz) { const bf16_t* kp = Z + (size_t)(row0 + tk) * NIN + ZC_K + kvh * 64 + p * 16; const bf16_t* vp = Z + (size_t)(row0 + tk) * NIN + ZC_V + kvh * 64 + p * 16;
            unpack8(*(const u32x4*)kp, kf, 0); unpack8(*(const u32x4*)(kp + 8), kf, 8); unpack8(*(const u32x4*)vp, vf, 0); unpack8(*(const u32x4*)(vp + 8), vf, 8); }
        if (frompast) { const GAS float* kp = C.cache_k() + (((size_t)b * 128 + (128 + tk)) * 4 + kvh) * 64 + p * 16; const GAS float* vp = C.cache_v() + (((size_t)b * 128 + (128 + tk)) * 4 + kvh) * 64 + p * 16;
#pragma unroll
            for (int j = 0; j < 4; ++j) { const f32x4 kv = *(const GAS f32x4*)(kp + 4 * j), vv = *(const GAS f32x4*)(vp + 4 * j);
#pragma unroll
                for (int e = 0; e < 4; ++e) { kf[4 * j + e] = kv[e]; vf[4 * j + e] = vv[e]; } } }
        float ss = 0.f;
#pragma unroll
        for (int j = 0; j < 16; ++j) ss += kf[j] * kf[j];
        ss += __shfl_xor(ss, 1); ss += __shfl_xor(ss, 2);
        if (fromz) { const float rs = rsqrtf(ss * (1.0f / 64.0f) + RMS_EPS);
#pragma unroll
            for (int j = 0; j < 16; ++j) kf[j] = kf[j] * rs * C.kn()[p * 16 + j];
            if (p == 0) { const float* rp = C.rope() + (size_t)(pidx0 + tk) * 16;
#pragma unroll
                for (int i = 0; i < 8; ++i) { const float cs = rp[i], sn = rp[8 + i], x1 = kf[i], x2 = kf[8 + i]; kf[i] = x1 * cs - x2 * sn; kf[8 + i] = x2 * cs + x1 * sn; } } }
        { u32x4 w0, w1; w0.x = cvt_pk_bf16(kf[0], kf[1]); w0.y = cvt_pk_bf16(kf[2], kf[3]); w0.z = cvt_pk_bf16(kf[4], kf[5]); w0.w = cvt_pk_bf16(kf[6], kf[7]);
          w1.x = cvt_pk_bf16(kf[8], kf[9]); w1.y = cvt_pk_bf16(kf[10], kf[11]); w1.z = cvt_pk_bf16(kf[12], kf[13]); w1.w = cvt_pk_bf16(kf[14], kf[15]);
          *(LAS u32x4*)(lds + s * (KS_STRIDE * 2) + p * 32) = w0; *(LAS u32x4*)(lds + s * (KS_STRIDE * 2) + p * 32 + 16) = w1; }
#pragma unroll
        for (int j = 0; j < 16; ++j) *(LAS bf16_t*)(lds + VT_OFF + (p * 16 + j) * (VT_STRIDE * 2) + s * 2) = f2bf(vf[j]);
        if (lastblk && s >= nq && s < nspan) { const int w = s - nq; float* ko = C.o_k(has_past) + (((size_t)b * 128 + w) * 4 + kvh) * 64 + p * 16; float* vo = C.o_v(has_past) + (((size_t)b * 128 + w) * 4 + kvh) * 64 + p * 16;
#pragma unroll
            for (int j = 0; j < 4; ++j) { *(f32x4*)(ko + 4 * j) = (f32x4){kf[4 * j], kf[4 * j + 1], kf[4 * j + 2], kf[4 * j + 3]}; *(f32x4*)(vo + 4 * j) = (f32x4){vf[4 * j], vf[4 * j + 1], vf[4 * j + 2], vf[4 * j + 3]}; } }
    }
    __syncthreads();
    if (nq == 128) attn_compute<true>(C, lds, Z, row0, q0, nq, nspan, pidx0, has_past, kvh, wid, lane);
    else attn_compute<false>(C, lds, Z, row0, q0, nq, nspan, pidx0, has_past, kvh, wid, lane);
    __syncthreads();
}

constexpr int LRU_WREG = 14976, LRU_WOFF = 8 * LRU_WREG, LRU_W1D = (RING_BYTES + 2048) - LRU_WOFF;
static_assert(LRU_WOFF + 9216 <= RING_BYTES && RING_BYTES + 2048 + 9216 <= LDS_BYTES, "LRU LDS map");
template <bool WLDS>
__device__ __forceinline__ void lru_local(const Ctx& C, LAS unsigned char* wl, const LAS unsigned char* wlds, int b, int row0, int T, int has_past, int h, int t0, int ntok, int lane, unsigned (&ub)[64], float& Aout, float& Hout) {
    const int ch = 64 * h + lane, fr = lane & 15, fq = lane >> 4;
    LAS bf16_t* xs = (LAS bf16_t*)wl;
    LAS bf16_t* xcb = (LAS bf16_t*)(wl + 2432);
    LAS float* gr = (LAS float*)(wl + 4736);
    LAS float* gi = (LAS float*)(wl + 4736 + 4096);
    LAS bf16_t* gs = (LAS bf16_t*)(wl + 12928);
    const float cw0 = C.conv_w()[ch], cw1 = C.conv_w()[1024 + ch], cw2 = C.conv_w()[2048 + ch], cw3 = C.conv_w()[3072 + ch], cb = C.conv_b()[ch];
    constexpr float LOG2E_F = 1.4426950408889634f;
    const float nba = -LOG2E_F * C.ba()[ch], nbx = -LOG2E_F * C.bx()[ch];
    float cs; { const float xl = -C.lam()[ch]; cs = (-8.0f * LOG2E_F) * (fmaxf(xl, 0.f) + log1pf(__expf(-fabsf(xl)))); }
    const bf16_t* wap = C.WaT() + h * 4096 + fr * 64 + 8 * fq; const bf16_t* wxp = C.WxT() + h * 4096 + fr * 64 + 8 * fq;
    float hloc = 0.f, aprod = 1.f;
    u32x4 nv[3], ng[2];
#define LRU_XLOAD(TBASE) do { _Pragma("unroll") for (int j = 0; j < 2; ++j) { const int idx = lane + 64 * j, r = idx >> 3, c8 = idx & 7, tt = (TBASE) + r; \
        unsigned zz = 0u; asm volatile("" : "+v"(zz)); u32x4 v; v.x = zz; v.y = zz; v.z = zz; v.w = zz; \
        if (tt < T) v = *(const u32x4*)(C.Z() + (size_t)(row0 + tt) * NIN + ZC_GL + 64 * h + 8 * c8); \
        ng[j] = v; } \
    _Pragma("unroll") for (int j = 0; j < 3; ++j) { const int idx = lane + 64 * j, r = idx >> 3, c8 = idx & 7, tt = (TBASE) - 3 + r; \
        if (idx < 152) { unsigned zz = 0u; asm volatile("" : "+v"(zz)); u32x4 v; v.x = zz; v.y = zz; v.z = zz; v.w = zz; \
            if (tt >= 0 && tt < T) v = *(const u32x4*)(C.Z() + (size_t)(row0 + tt) * NIN + ZC_XL + 64 * h + 8 * c8); \
            else if (tt < 0 && has_past) { const GAS float* pp = C.state_conv() + ((size_t)b * 3 + (3 + tt)) * 1024 + 64 * h + 8 * c8; const f32x4 p0 = *(const GAS f32x4*)pp, p1 = *(const GAS f32x4*)(pp + 4); \
                v.x = cvt_pk_bf16(p0[0], p0[1]); v.y = cvt_pk_bf16(p0[2], p0[3]); v.z = cvt_pk_bf16(p1[0], p1[1]); v.w = cvt_pk_bf16(p1[2], p1[3]); } \
            nv[j] = v; } } } while (0)
    { unsigned zz = 0u; asm volatile("" : "+v"(zz)); nv[0].x = zz; nv[0].y = zz; nv[0].z = zz; nv[0].w = zz; nv[1] = nv[0]; nv[2] = nv[0]; ng[0] = nv[0]; ng[1] = nv[0]; }
    LRU_XLOAD(t0);
#pragma unroll
    for (int tb = 0; tb < 4; ++tb) {
        if (16 * tb < ntok) {
#pragma unroll
            for (int j = 0; j < 3; ++j) { const int idx = lane + 64 * j; if (idx < 152) *(LAS u32x4*)(xs + (idx >> 3) * 64 + 8 * (idx & 7)) = nv[j]; }
#pragma unroll
            for (int j = 0; j < 2; ++j) { const int idx = lane + 64 * j; *(LAS u32x4*)(gs + (idx >> 3) * 64 + 8 * (idx & 7)) = ng[j]; }
            __builtin_amdgcn_sched_barrier(0);
            if (16 * (tb + 1) < ntok) LRU_XLOAD(t0 + 16 * (tb + 1));
            __builtin_amdgcn_sched_barrier(0);
            LDS_WAIT();
            float xr[19], xc[16];
#pragma unroll
            for (int r = 0; r < 19; ++r) xr[r] = bf1(xs[r * 64 + lane]);
#pragma unroll
            for (int k = 0; k < 16; ++k) { xc[k] = __builtin_fmaf(cw3, xr[k + 3], __builtin_fmaf(cw2, xr[k + 2], __builtin_fmaf(cw1, xr[k + 1], __builtin_fmaf(cw0, xr[k], cb)))); xcb[k * 72 + lane] = f2bf(xc[k]); }
            LDS_WAIT();
            { bf16x8 af[2];
#pragma unroll
              for (int ks = 0; ks < 2; ++ks) af[ks] = *(const LAS bf16x8*)(xcb + fr * 72 + 32 * ks + 8 * fq);
#pragma unroll
              for (int db = 0; db < 4; ++db) { f32x4 ar = (f32x4){0.f, 0.f, 0.f, 0.f}, ai = (f32x4){0.f, 0.f, 0.f, 0.f};
#pragma unroll
                  for (int ks = 0; ks < 2; ++ks) { bf16x8 wav, wxv;
                      if (WLDS) { wav = *(const LAS bf16x8*)(wlds + ((16 * db + fr) * 72 + 32 * ks + 8 * fq) * 2); wxv = *(const LAS bf16x8*)(wlds + LRU_W1D + ((16 * db + fr) * 72 + 32 * ks + 8 * fq) * 2); }
                      else { wav = *(const bf16x8*)(wap + db * 1024 + 32 * ks); wxv = *(const bf16x8*)(wxp + db * 1024 + 32 * ks); }
                      ar = __builtin_amdgcn_mfma_f32_16x16x32_bf16(af[ks], wav, ar, 0, 0, 0); ai = __builtin_amdgcn_mfma_f32_16x16x32_bf16(af[ks], wxv, ai, 0, 0, 0); }
#pragma unroll
                  for (int i = 0; i < 4; ++i) { gr[(4 * fq + i) * 64 + 16 * db + fr] = ar[i]; gi[(4 * fq + i) * 64 + 16 * db + fr] = ai[i]; } } }
            LDS_WAIT();
            int gbase = lane;
#pragma unroll
            for (int k = 0; k < 16; ++k) {
                if ((k & 3) == 0) asm volatile("" : "+v"(gbase), "+v"(hloc), "+v"(aprod));
                const float r = __builtin_amdgcn_rcpf(1.0f + __builtin_amdgcn_exp2f(__builtin_fmaf(gr[k * 64 + gbase], -LOG2E_F, nba)));
                const float ig = __builtin_amdgcn_rcpf(1.0f + __builtin_amdgcn_exp2f(__builtin_fmaf(gi[k * 64 + gbase], -LOG2E_F, nbx)));
                const float aa = __builtin_amdgcn_exp2f(r * cs), bb = __builtin_amdgcn_sqrtf(__builtin_fmaf(-aa, aa, 1.0f)) * ig * xc[k];
                const float gl = bf1(gs[k * 64 + gbase]);
                const float eg = __builtin_amdgcn_exp2f(gl * __builtin_fmaf(gl * gl, 0.10294324f, 2.3022082f));
                float G = __builtin_fmaf(-gl, __builtin_amdgcn_rcpf(1.0f + eg), gl);
                const bool live = 16 * tb + k < ntok;
                float av = live ? aa : 1.0f, bm = live ? bb : 0.f;
                asm("" : "+v"(G)); asm("" : "+v"(av)); asm("" : "+v"(bm));
                hloc = av * hloc + bm; aprod *= av;
                float pg = aprod * G, hg = hloc * G; asm("" : "+v"(pg)); asm("" : "+v"(hg));
                unsigned pk = cvt_pk_bf16(pg, hg); ub[16 * tb + k] = live ? pk : 0u;
                }
            LDS_WAIT();
        } else {
#pragma unroll
            for (int k = 0; k < 16; ++k) ub[16 * tb + k] = 0u;
        }
    }
#undef LRU_XLOAD
    Aout = aprod; Hout = hloc;
}
__device__ __forceinline__ void lru_final(const Ctx& C, int row0, int h, int t0, int ntok, int lane, const unsigned (&ub)[64], float carry) {
    const int ch = 64 * h + lane;
    bf16_t* yo = C.BR() + (size_t)(row0 + t0) * NBR + BRC_LRU + ch;
#pragma unroll
    for (int k = 0; k < 64; ++k) { if (k < ntok) yo[(size_t)k * NBR] = f2bf(bf_hi(ub[k]) + bf_lo(ub[k]) * carry); }
}
__device__ __forceinline__ void lru_states(const Ctx& C, int has_past, int b, int row0, int T, int h, int lane, float hend) {
    const int ch = 64 * h + lane;
    C.o_h(has_past)[b * 1024 + ch] = hend;
#pragma unroll
    for (int j = 0; j < 3; ++j) C.o_conv(has_past)[((size_t)b * 3 + j) * 1024 + ch] = bf1(C.Z()[(size_t)(row0 + T - 3 + j) * NIN + ZC_XL + ch]);
}
#define RLX_AGENT __ATOMIC_RELAXED, __HIP_MEMORY_SCOPE_AGENT
__device__ __forceinline__ void lru_prompt_item(const Ctx& C, LAS unsigned char* lds, int item, int wave, int lane) {
    const int s = item >> 6, seq = (item >> 4) & 3, h = item & 15, row0 = seq * 2048, t0 = 512 * s + 64 * wave;
    unsigned ub[64]; float Ac, Hc;
    { const int t = wave * 64 + lane, mat = t >> 8, r = (t >> 2) & 63, ch4 = t & 3; const bf16_t* src = (mat ? C.WxT() : C.WaT()) + h * 4096 + r * 64 + ch4 * 16;
      const u32x4 v0 = *(const u32x4*)src, v1 = *(const u32x4*)(src + 8); LAS unsigned char* dst = lds + LRU_WOFF + mat * LRU_W1D + r * 144 + ch4 * 32;
      *(LAS u32x4*)dst = v0; *(LAS u32x4*)(dst + 16) = v1; }
    __syncthreads();
    lru_local<true>(C, lds + wave * LRU_WREG, lds + LRU_WOFF, seq, row0, 2048, 0, h, t0, 64, lane, ub, Ac, Hc);
    asm volatile("" : "+v"(Ac)); asm volatile("" : "+v"(Hc));
    __syncthreads();
    LAS float* xA = (LAS float*)lds; LAS float* xH = xA + 512;
    xA[wave * 64 + lane] = Ac; xH[wave * 64 + lane] = Hc;
    __syncthreads();
    float Apre = 1.f, Hpre = 0.f, Atot = 1.f, Htot = 0.f;
#pragma unroll
    for (int w = 0; w < 8; ++w) { float va = xA[w * 64 + lane], vh = xH[w * 64 + lane]; asm volatile("" : "+v"(va)); asm volatile("" : "+v"(vh));
        if (w < wave) { Hpre = va * Hpre + vh; Apre *= va; } Htot = va * Htot + vh; Atot *= va; }
    typedef GAS unsigned long long gu64;
    gu64* gbase = (gu64*)(C.ws + WS_LRUG); const unsigned tag = (unsigned)C.l + 1u;
    if (wave == 0) { gu64* gp = gbase + (size_t)item * 128 + 2 * lane;
        __hip_atomic_store(gp, ((unsigned long long)tag << 32) | __float_as_uint(Atot), RLX_AGENT); __hip_atomic_store(gp + 1, ((unsigned long long)tag << 32) | __float_as_uint(Htot), RLX_AGENT); }
    float hin = 0.f;
    for (int sp = 0; sp < s; ++sp) { gu64* gp = gbase + (size_t)(sp * 64 + seq * 16 + h) * 128 + 2 * lane; unsigned long long x0 = 0, x1 = 0;
        for (unsigned spins = 0; spins < (1u << 16); ++spins) { x0 = __hip_atomic_load(gp, RLX_AGENT); x1 = __hip_atomic_load(gp + 1, RLX_AGENT);
            if (__all((unsigned)(x0 >> 32) == tag && (unsigned)(x1 >> 32) == tag)) break; __builtin_amdgcn_s_sleep(2); }
        hin = __uint_as_float((unsigned)x0) * hin + __uint_as_float((unsigned)x1); }
    const float carry = Apre * hin + Hpre;
    lru_final(C, row0, h, t0, 64, lane, ub, carry);
    if (s == 3 && wave == 7) lru_states(C, 0, seq, row0, 2048, h, lane, Ac * carry + Hc);
    __syncthreads();
}
__device__ __forceinline__ void lru_sample_item(const Ctx& C, LAS unsigned char* wl, int item, int lane) {
    const int b = item >> 4, h = item & 15, row0 = MP + 8 * b;
    unsigned ub[64]; float Ac, Hc;
    lru_local<false>(C, wl, nullptr, b, row0, 8, 1, h, 0, 8, lane, ub, Ac, Hc);
    const float carry = C.state_h()[b * 1024 + 64 * h + lane];
    lru_final(C, row0, h, 0, 8, lane, ub, carry);
    lru_states(C, 1, b, row0, 8, h, lane, Ac * carry + Hc);
}

__device__ __forceinline__ void pool_group(const Ctx& C, int grp, int lane) {
    const int rowA = 4 * grp; int b, tA, has_past, posA, row0;
    if (rowA < MP) { b = rowA >> 11; tA = rowA & 2047; has_past = 0; posA = tA; row0 = b * 2048; } else { b = (rowA - MP) >> 3; tA = (rowA - MP) & 7; has_past = 1; posA = 16384 + tA; row0 = MP + 8 * b; }
#pragma unroll
    for (int step = 0; step < 2; ++step) { const int cidx = lane + 64 * step, g = cidx >> 5, w = 2 << g;
        float S[4][8], U[4][8];
#pragma unroll
        for (int r = 0; r < 4; ++r)
#pragma unroll
            for (int e = 0; e < 8; ++e) { S[r][e] = 0.f; U[r][e] = 0.f; }
#pragma unroll
        for (int d = 0; d < 19; ++d) { const int tt = tA + 3 - d; float v[8];
#pragma unroll
            for (int e = 0; e < 8; ++e) v[e] = 0.f;
            if (d < w + 3) {
                if (tt >= 0) { const u32x4 q = *(const u32x4*)(C.Z() + (size_t)(row0 + tt) * NIN + 8 * cidx); v[0] = bf_lo(q.x); v[1] = bf_hi(q.x); v[2] = bf_lo(q.y); v[3] = bf_hi(q.y); v[4] = bf_lo(q.z); v[5] = bf_hi(q.z); v[6] = bf_lo(q.w); v[7] = bf_hi(q.w); }
                else if (has_past) { const GAS float* pp = C.state_pool() + ((size_t)b * 15 + (15 + tt)) * 1024 + 8 * cidx; const f32x4 p0 = *(const GAS f32x4*)pp, p1 = *(const GAS f32x4*)(pp + 4);
                    v[0] = p0[0]; v[1] = p0[1]; v[2] = p0[2]; v[3] = p0[3]; v[4] = p1[0]; v[5] = p1[1]; v[6] = p1[2]; v[7] = p1[3]; } }
#pragma unroll
            for (int r = 0; r < 4; ++r) { if (d >= r) { const bool in = (d < r + w);
#pragma unroll
                for (int e = 0; e < 8; ++e) { S[r][e] += in ? v[e] : 0.f; if (d == r) U[r][e] = v[e]; } } } }
#pragma unroll
        for (int r = 0; r < 4; ++r) { const int pos = posA + 3 - r; const int cnt = (pos + 1) < w ? (pos + 1) : w; const float ic = 1.0f / (float)cnt; float dd[8];
#pragma unroll
            for (int e = 0; e < 8; ++e) dd[e] = S[r][e] * ic - U[r][e];
            u32x4 o; o.x = cvt_pk_bf16(dd[0], dd[1]); o.y = cvt_pk_bf16(dd[2], dd[3]); o.z = cvt_pk_bf16(dd[4], dd[5]); o.w = cvt_pk_bf16(dd[6], dd[7]);
            *(u32x4*)(C.BR() + (size_t)(rowA + 3 - r) * NBR + BRC_POOL + 8 * cidx) = o; } }
}
__device__ __forceinline__ void newpool_item(const Ctx& C, int item, int lane) {
    const int seq = item / 15, j = item - seq * 15; int b, T, row0, has_past;
    if (seq < 4) { b = seq; T = 2048; row0 = seq * 2048; has_past = 0; } else { b = seq - 4; T = 8; row0 = MP + 8 * b; has_past = 1; }
    const int fi = T + j; float* o = C.o_pool(has_past) + ((size_t)b * 15 + j) * 1024;
#pragma unroll
    for (int k = 0; k < 4; ++k) { const int c = 4 * lane + 256 * k; f32x4 v = (f32x4){0.f, 0.f, 0.f, 0.f};
        if (fi >= 15) { const u32x2 q = *(const u32x2*)(C.Z() + (size_t)(row0 + fi - 15) * NIN + c); v[0] = bf_lo(q.x); v[1] = bf_hi(q.x); v[2] = bf_lo(q.y); v[3] = bf_hi(q.y); }
        else if (has_past) v = *(const GAS f32x4*)(C.state_pool() + ((size_t)b * 15 + fi) * 1024 + c);
        *(f32x4*)(o + c) = v; }
}

__global__ void __launch_bounds__(512, 2) fwd(Args args) {
    extern __shared__ __attribute__((aligned(16))) unsigned char lds_raw[];
    LAS unsigned char* lds = (LAS unsigned char*)lds_raw;
    const int tid = threadIdx.x, lane = tid & 63, wave = __builtin_amdgcn_readfirstlane(tid >> 6);
    const int G = gridDim.x, bx = blockIdx.x, vcu = (G % 8 == 0) ? (bx % 8) * (G / 8) + bx / 8 : bx;
    const int gw = vcu * 8 + wave, NGW = G * 8;
    unsigned char* ws = args.ws;
    unsigned* ctl = (unsigned*)(ws + WS_CTL);
    for (int u = tid; u < (LDS_BYTES - LDSCTL_OFF) / 4; u += 512) ((LAS unsigned*)(lds + LDSCTL_OFF))[u] = 0u;
    __syncthreads();
    XcdBarrier bar; bar.bar = ctl + CW_BAR; bar.x = 0; bar.st = nullptr;
    if (!MK_PER_PHASE) bar = xcd_barrier_post(ctl + CW_BAR, (volatile LAS unsigned*)(lds + MISC_OFF) + 8);
    const int lo = args.ph_lo, hi = args.ph_hi;
    int pid = 0;
#define IN(k) (lo <= (k) && (k) < hi)
#ifndef SEAM_REPS
#define SEAM_REPS 1
#endif
#ifndef DNX
#define DNX 8
#endif
#ifndef SLOT_GU
#define SLOT_GU 40
#endif
#ifndef SLOT_IN
#define SLOT_IN 40
#endif
    unsigned* sptr = ctl + CW_SPTR; volatile LAS unsigned* bar_st = (volatile LAS unsigned*)(lds + MISC_OFF) + 8;
#define SEAM(PSV, NEED) do { if (IN(pid)) { int stid = threadIdx.x; asm volatile("" : "+v"(stid)); const int swv = __builtin_amdgcn_readfirstlane(stid >> 6); \
            (void)swv; if ((NEED) > 0) convert_wg(PSV, ws, lds, bar_st, sptr, (NEED), 0); \
            if (!MK_PER_PHASE && IN(pid + 1)) { xcd_barrier(bar); } } ++pid; } while (0)
    const PSTbl PT{(const float* const*)(ws + WS_TBL)}; const PSArgs PA{&args};
    float* X = args.out;
    bf16_t* XB = (bf16_t*)(ws + WS_XB); bf16_t* ACT = (bf16_t*)(ws + WS_ACT); bf16_t* Zb = (bf16_t*)(ws + WS_Z); bf16_t* BR = (bf16_t*)(ws + WS_BR);
    bf16_t* MB = (bf16_t*)(ws + WS_MB);
    u64* SS = (u64*)(ws + WS_CTL + (size_t)CW_SS * 4);

    if (EN(0) && IN(pid)) { for (int rep = 0; rep < REPS(0); ++rep) prologue(args, lds, gw, NGW, wave, lane); }
    SEAM(PA, tt_need(0, 0));
#pragma unroll 1
    for (int s = 0; s < 8; ++s) {
        const int l = s >> 1, which = s & 1;
        unsigned char* lw = ws + WS_W + (size_t)l * LW_STRIDE;
        if (EN(2) && IN(pid)) {
            pg8::Gemm g{XB, (const bf16_t*)(lw + (which ? LW_GUB : LW_GUA)), D, D, D};
            pg8::OrderStd S; S.init(M / 256, NGU / 256, 1, G, bx, D, D, 0, 0);
            pg8::EpiGU E{ACT, SS + (size_t)(3 * l + 2 * which) * M};
            for (int rep = 0; rep < REPS(2); ++rep) pg8::gemm_phase<false>(lds, g, S, E);
            if (s == 0) {
                const int nwg_ = (M / 256) * (NGU / 256), nmax_ = (nwg_ + G - 1) / G, nfull_ = nwg_ - (nmax_ - 1) * G, nidle_ = G - nfull_;
                if (nidle_ == 0 || bx >= nfull_) {
                    pg8::Gemm gw_{(const bf16_t*)(ws + WS_WBPT), (const bf16_t*)(ws + WS_PP), 1024, 256, 256};
                    pg8::OrderWeff Sw{nidle_ == 0 ? G : nidle_, nidle_ == 0 ? bx : bx - nfull_}; pg8::EpiWeff Ew{(bf16_t*)(ws + WS_W + LW_CAT)};
                    pg8::gemm_phase<false>(lds, gw_, Sw, Ew); }
            }
            {
                const int nwg_ = (M / 256) * (NGU / 256), nmax_ = (nwg_ + G - 1) / G, nfull_ = nwg_ - (nmax_ - 1) * G, nidle_ = G - nfull_;
                if (nidle_ == 0 || bx >= nfull_) { int ptid = threadIdx.x; asm volatile("" : "+v"(ptid)); const int plane = ptid & 63, pwave = __builtin_amdgcn_readfirstlane(ptid >> 6);
                    const PSTbl P{(const float* const*)(ws + WS_TBL)};
                    convert_wg(P, ws, lds, bar_st, sptr, TT_TOTAL, s == 0 ? SLOT_GU - 16 : SLOT_GU);     (void)plane; (void)pwave; }
            }
        }
        SEAM(PT, tt_need(l, which ? 7 : 1));
        if (EN(3) && IN(pid)) {
            pg8::Gemm g{ACT, (const bf16_t*)(lw + (which ? LW_DNB : LW_DNA)), FF, FF, FF};
            pg8::OrderRide S; S.init(G, bx, FF, FF);
            pg8::EpiRes E{(s == 7) ? X : nullptr, XB, SS + (size_t)(3 * l + 2 * which + 1) * M, 0.5f};
            pg8::gemm_phase<true>(lds, g, S, E);
            { pg8::Unit u0; if (DNX > 0 && S.next(0, u0) && u0.xrow < 0) convert_wg(PT, ws, lds, bar_st, sptr, TT_TOTAL, DNX); }
            if (REPS(3) > 1) { __syncthreads(); pg8::EpiRes E2{nullptr, XB, (u64*)(ws + WS_MRG), 0.0f}; pg8::gemm_phase<true>(lds, g, S, E2); }
        }
        SEAM(PT, (which == 0) ? tt_need(l, 2) : (l + 1 < DEPTH ? tt_need(l + 1, 0) : 0));
        if (which == 0) {
            if (EN(4) && IN(pid)) {
                pg8::Gemm g{XB, (const bf16_t*)(lw + LW_IN), D, D, D};
                pg8::OrderStd S; S.init(M / 256, NIN / 256, 1, G, bx, D, D, 0, 0);
                pg8::EpiIn E{Zb, SS + (size_t)(3 * l + 1) * M};
                for (int rep = 0; rep < REPS(4); ++rep) pg8::gemm_phase<false>(lds, g, S, E);
            {
                    const int nwg_ = (M / 256) * (NIN / 256), nmax_ = (nwg_ + G - 1) / G, nfull_ = nwg_ - (nmax_ - 1) * G, nidle_ = G - nfull_;
                    if (nidle_ == 0 || bx >= nfull_) { int ptid = threadIdx.x; asm volatile("" : "+v"(ptid)); const int plane = ptid & 63, pwave = __builtin_amdgcn_readfirstlane(ptid >> 6);
                        const PSTbl P{(const float* const*)(ws + WS_TBL)};
                        convert_wg(P, ws, lds, bar_st, sptr, TT_TOTAL, SLOT_IN); (void)plane; (void)pwave; }
                }
            }
            SEAM(PT, tt_need(l, 3));
            Ctx C; C.tbl = (const float* const*)(ws + WS_TBL); C.ws = ws; C.out = X; C.l = l;
            if (IN(pid)) {
                _Pragma("unroll 1") for (int rep = 0; rep < REPS(5); ++rep) {
                int ptid = threadIdx.x; asm volatile("" : "+v"(ptid)); const int plane = ptid & 63, pwave = __builtin_amdgcn_readfirstlane(ptid >> 6), pgw = vcu * 8 + pwave;
                _Pragma("unroll 1") for (int r2 = 0; r2 < REPS(11); ++r2) { if (EN(6)) for (int it = bx; it < 256; it += G) lru_prompt_item(C, lds, it, pwave, plane); }
                _Pragma("unroll 1") for (int r2 = 0; r2 < REPS(12); ++r2) { if (EN(5)) for (int a = bx; a < N_ATT_UNITS; a += G) attn_unit(C, lds, a, ptid, pwave, plane); }
                __syncthreads();
                if (EN(6)) for (int it = NGW - 1 - (bx * 8 + pwave); it < 512; it += NGW) lru_sample_item(C, lds + pwave * 16384, it, plane);
                { const int wlo = bx * 8 + pwave, half = (G / 2) * 8, nhi = NGW - half, NG4 = M / 4; const int share_hi = nhi > 0 ? (NG4 * 5) / 6 : 0;
                  if (EN(7)) { if (wlo >= half) { for (int g4 = wlo - half; g4 < share_hi; g4 += nhi) pool_group(C, g4, plane); for (int it = wlo - half; it < NSEQ * 15; it += nhi) newpool_item(C, it, plane); }
                               else { for (int g4 = share_hi + wlo; g4 < NG4; g4 += half) pool_group(C, g4, plane); }
                               if (nhi <= 0) for (int it = wlo; it < NSEQ * 15; it += NGW) newpool_item(C, it, plane); } }
                __syncthreads(); }
            }
            SEAM(PT, tt_need(l, 4));
            if (EN(9) && IN(pid)) {
                pg8::Gemm g{BR, (const bf16_t*)(lw + LW_CAT), NBR, NBR, NBR};
                pg8::OrderRide S; S.init(G, bx, NBR, NBR);
                pg8::EpiBr E{Zb, MB};
                for (int rep = 0; rep < REPS(9); ++rep) pg8::gemm_phase<true>(lds, g, S, E);
            }
            SEAM(PT, tt_need(l, 5));
            if (EN(10) && IN(pid)) {
                pg8::Gemm g{MB, (const bf16_t*)(lw + LW_OUT), D, D, D};
                pg8::OrderRide S; S.init(G, bx, D, D);
                pg8::EpiRes E{nullptr, XB, SS + (size_t)(3 * l + 2) * M, 1.0f};
                pg8::gemm_phase<true>(lds, g, S, E);
                if (REPS(10) > 1) { __syncthreads(); pg8::EpiRes E2{nullptr, XB, (u64*)(ws + WS_MRG), 0.0f}; pg8::gemm_phase<true>(lds, g, S, E2); }
            }
            SEAM(PT, tt_need(l, 6));
        }
    }
#undef IN
#undef SEAM
}
constexpr int N_PHASES = 1 + 4 * 8;

extern "C" void kernel_launch(void* const* d_in, const int* in_sizes, int n_in, void* d_out, int out_size, void* d_ws, size_t ws_size, hipStream_t stream) {
    static int grid = 0;
    if (grid == 0) {
        if (n_in != 31 || (size_t)out_size != O_END || ws_size < WS_END) { fprintf(stderr, "kernel_launch: unexpected shapes: n_in %d out %d (want %zu) ws %zu (want >= %zu)\n", n_in, out_size, (size_t)O_END, ws_size, (size_t)WS_END); grid = -1; return; }
        int dev = 0, cus = 0, per_cu = 0;
        if (hipGetDevice(&dev) != hipSuccess || hipDeviceGetAttribute(&cus, hipDeviceAttributeMultiprocessorCount, dev) != hipSuccess) { grid = -1; return; }
        if (hipFuncSetAttribute((const void*)fwd, hipFuncAttributeMaxDynamicSharedMemorySize, LDS_BYTES) != hipSuccess) { fprintf(stderr, "kernel_launch: hipFuncSetAttribute failed\n"); grid = -1; return; }
        if (hipOccupancyMaxActiveBlocksPerMultiprocessor(&per_cu, (const void*)fwd, 512, LDS_BYTES) != hipSuccess || per_cu < 1) fprintf(stderr, "kernel_launch: occupancy query says %d\n", per_cu);
        (void)hipGetLastError();
        grid = cus;
    }
    if (grid < 0) return;
    if (hipMemsetAsync((char*)d_ws + WS_CTL, 0, CTL_BYTES, stream) != hipSuccess) return;
    Args a{};
    for (int i = 0; i < 31; ++i) a.in[i] = (const float*)d_in[i];
    a.out = (float*)d_out; a.ws = (unsigned char*)d_ws;
#if MK_PER_PHASE
    for (int p = 0; p < N_PHASES; ++p) { a.ph_lo = p; a.ph_hi = p + 1; hipLaunchKernelGGL(fwd, dim3(grid), dim3(512), LDS_BYTES, stream, a); }
#else
    a.ph_lo = 0; a.ph_hi = N_PHASES;
    hipLaunchKernelGGL(fwd, dim3(grid), dim3(512), LDS_BYTES, stream, a);
#endif
}
```
